# Optimizing an MI355X kernel written in HIP

```python
import math
import jax, jax.numpy as jnp
from jax import lax
import numpy as np

D_MODEL = 1024
BATCH = 8
SEQ = 4096
DEPTH = 2

HEAD_DIM = 64
N_HEADS_A = D_MODEL // HEAD_DIM
MOBA_BLOCK = 256
MOBA_TOPK = 3
MOBA_Q_CHUNK = 16
N_HEADS_B = D_MODEL // HEAD_DIM
N_KV_B = max(1, N_HEADS_B // 8)
WINDOW = 128
D_FF = 256 * math.ceil(8 * D_MODEL / 3 / 256)
N_EXPERTS = 8
MOE_TOPK = 2
D_FF_EXPERT = 7 * D_MODEL // 2
N_A = max(1, DEPTH // 2)
N_B = DEPTH - N_A
N_DENSE = (DEPTH + 1) // 2
N_MOE = DEPTH // 2
DEEPNORM_ALPHA = (2 * DEPTH) ** 0.25
DEEPNORM_BETA = (8 * DEPTH) ** -0.25
LN_EPS = 1e-5
NEG_INF = -1e30

kernel_name = 'hybrid_moba_swa_sinks_yoco_deepnorm_moe'


def layer_norm(x, g, b):
    xf = x.astype(jnp.float32)
    mu = xf.mean(-1, keepdims=True)
    var = jnp.square(xf - mu).mean(-1, keepdims=True)
    return ((xf - mu) * lax.rsqrt(var + LN_EPS) * g.astype(jnp.float32) + b.astype(jnp.float32)).astype(x.dtype)


def alibi_slopes(n):
    return jnp.exp2(-8.0 * jnp.arange(1, n + 1, dtype=jnp.float32) / n)


def moba_attention(x, w_qkv, w_o):
    B, T, _ = x.shape
    H, hd, BS, QC = N_HEADS_A, HEAD_DIM, MOBA_BLOCK, MOBA_Q_CHUNK
    q, k, v = jnp.split(x @ w_qkv, 3, axis=-1)
    Tp = -(-T // BS) * BS
    pad = Tp - T

    def heads(t):
        t = jnp.pad(t, ((0, 0), (0, pad), (0, 0)))
        return t.reshape(B, Tp, H, hd).transpose(0, 2, 1, 3)

    q, k, v = heads(q), heads(k), heads(v)
    NB = Tp // BS
    k_blocks = k.reshape(B, H, NB, BS, hd)
    v_blocks = v.reshape(B, H, NB, BS, hd)
    k_mean = k_blocks.astype(jnp.float32).mean(axis=3)
    gate = jnp.einsum('bhtd,bhnd->bhtn', q.astype(jnp.float32), k_mean)
    q_blk = jnp.arange(Tp) // BS
    past = jnp.arange(NB)[None, :] < q_blk[:, None]
    gate = jnp.where(past, gate, NEG_INF)
    k_sel = min(MOBA_TOPK, NB)
    _, sel = lax.top_k(gate, k_sel)
    NC = Tp // QC
    q_c = (q * hd ** -0.5).reshape(B, H, NC, QC, hd).transpose(2, 0, 1, 3, 4)
    sel_c = sel.reshape(B, H, NC, QC, k_sel).transpose(2, 0, 1, 3, 4)
    slopes = alibi_slopes(H)
    pos_in_blk = jnp.arange(BS)
    gather = jax.vmap(jax.vmap(lambda blocks, ix: blocks[ix]))

    def chunk(args):
        c, qc, ix = args
        t = c * QC + jnp.arange(QC)
        blk = (c * QC) // BS
        k_own = lax.dynamic_index_in_dim(k_blocks, blk, axis=2, keepdims=False)
        v_own = lax.dynamic_index_in_dim(v_blocks, blk, axis=2, keepdims=False)
        d_own = (t[:, None] - (blk * BS + pos_in_blk)[None, :]).astype(jnp.float32)
        l_own = jnp.einsum('bhqd,bhsd->bhqs', qc, k_own).astype(jnp.float32) - slopes[None, :, None, None] * d_own
        l_own = jnp.where(d_own >= 0, l_own, NEG_INF)
        kg = gather(k_blocks, ix)
        vg = gather(v_blocks, ix)
        d_sel = (t[None, None, :, None, None] - (ix[..., None] * BS + pos_in_blk)).astype(jnp.float32)
        l_sel = jnp.einsum('bhqd,bhqnsd->bhqns', qc, kg).astype(jnp.float32) - slopes[None, :, None, None, None] * d_sel
        l_sel = jnp.where((ix < blk)[..., None], l_sel, NEG_INF).reshape(B, H, QC, k_sel * BS)
        p = jax.nn.softmax(jnp.concatenate([l_own, l_sel], axis=-1), axis=-1)
        p_own = p[..., :BS].astype(v.dtype)
        p_sel = p[..., BS:].reshape(B, H, QC, k_sel, BS).astype(v.dtype)
        return jnp.einsum('bhqs,bhsd->bhqd', p_own, v_own) + jnp.einsum('bhqns,bhqnsd->bhqd', p_sel, vg)

    o = lax.map(chunk, (jnp.arange(NC), q_c, sel_c))
    o = o.transpose(1, 0, 3, 2, 4).reshape(B, Tp, H * hd)[:, :T]
    return o @ w_o


def swa_sinks_attention(x, w_q, w_o, sinks, k, v):
    B, T, _ = x.shape
    H, KV, hd, W = N_HEADS_B, N_KV_B, HEAD_DIM, WINDOW
    G = H // KV
    NB = T // W
    q = (x @ w_q).reshape(B, NB, W, KV, G, hd) * hd ** -0.5

    def band(t):
        tb = t.reshape(B, NB, W, KV, hd)
        prev = jnp.pad(tb, ((0, 0), (1, 0), (0, 0), (0, 0), (0, 0)))[:, :-1]
        return jnp.concatenate([prev, tb], axis=2)

    kb, vb = band(k), band(v)
    logits = jnp.einsum('bnqkgd,bnskd->bkgnqs', q, kb).astype(jnp.float32)
    s_idx = jnp.arange(2 * W)
    d = W + jnp.arange(W)[:, None] - s_idx[None, :]
    slopes = alibi_slopes(H).reshape(KV, G)[None, :, :, None, None, None]
    logits = logits - slopes * d.astype(jnp.float32)
    key_pos = jnp.arange(NB)[:, None, None] * W - W + s_idx[None, None, :]
    mask = ((d >= 0) & (d < W))[None] & (key_pos >= 0)
    logits = jnp.where(mask, logits, NEG_INF)
    sink = jnp.broadcast_to(sinks.reshape(KV, G).astype(jnp.float32)[None, :, :, None, None, None],
                            logits.shape[:-1] + (1,))
    p = jax.nn.softmax(jnp.concatenate([logits, sink], axis=-1), axis=-1)[..., :-1]
    o = jnp.einsum('bkgnqs,bnskd->bnqkgd', p.astype(v.dtype), vb).reshape(B, T, H * hd)
    return o @ w_o


def swiglu(x, w_gate, w_up, w_down):
    return (jax.nn.silu(x @ w_gate) * (x @ w_up)) @ w_down


def moe_swiglu(x, w_router, w_gate, w_up, w_down):
    B, T, D = x.shape
    xt = x.reshape(B * T, D)
    logits = (xt @ w_router).astype(jnp.float32)
    top_val, top_idx = lax.top_k(logits, MOE_TOPK)
    top_w = jax.nn.softmax(top_val, axis=-1)
    gates = jnp.sum(jax.nn.one_hot(top_idx, N_EXPERTS, dtype=jnp.float32) * top_w[..., None], axis=1)
    y = jnp.zeros_like(xt)
    for e in range(N_EXPERTS):
        y = y + gates[:, e:e + 1].astype(x.dtype) * swiglu(xt, w_gate[e], w_up[e], w_down[e])
    return y.reshape(B, T, D)


def setup_inputs(seed: int = 0) -> dict:
    key = jax.random.key(seed)
    ks = jax.random.split(key, 20)
    D = D_MODEL
    HA = N_HEADS_A * HEAD_DIM
    HB = N_HEADS_B * HEAD_DIM
    KVB = N_KV_B * HEAD_DIM
    beta = DEEPNORM_BETA

    def nrm(k, shape, fan_in, scale=1.0):
        return jax.random.normal(k, shape, jnp.float32) * (scale * fan_in ** -0.5)

    x = jax.random.normal(ks[0], (BATCH, SEQ, D), jnp.float32)
    w_qkv_a = jnp.concatenate([nrm(ks[1], (N_A, D, 2 * HA), D), nrm(ks[2], (N_A, D, HA), D, beta)], axis=-1)
    w_o_a = nrm(ks[3], (N_A, HA, D), HA, beta)
    w_kv_shared = jnp.concatenate([nrm(ks[4], (D, KVB), D), nrm(ks[5], (D, KVB), D, beta)], axis=-1)
    w_q_b = nrm(ks[6], (N_B, D, HB), D)
    w_o_b = nrm(ks[7], (N_B, HB, D), HB, beta)
    sinks_b = 0.5 * jax.random.normal(ks[8], (N_B, N_HEADS_B), jnp.float32)
    w_gate_d = nrm(ks[9], (N_DENSE, D, D_FF), D, beta)
    w_up_d = nrm(ks[10], (N_DENSE, D, D_FF), D, beta)
    w_down_d = nrm(ks[11], (N_DENSE, D_FF, D), D_FF, beta)
    w_router = nrm(ks[12], (N_MOE, D, N_EXPERTS), D)
    w_gate_e = nrm(ks[13], (N_MOE, N_EXPERTS, D, D_FF_EXPERT), D, beta)
    w_up_e = nrm(ks[14], (N_MOE, N_EXPERTS, D, D_FF_EXPERT), D, beta)
    w_down_e = nrm(ks[15], (N_MOE, N_EXPERTS, D_FF_EXPERT, D), D_FF_EXPERT, beta)
    ln_gain = 1.0 + 0.05 * jax.random.normal(ks[16], (DEPTH, 2, D), jnp.float32)
    ln_bias = 0.02 * jax.random.normal(ks[17], (DEPTH, 2, D), jnp.float32)
    return {'x': x, 'w_qkv_a': w_qkv_a, 'w_o_a': w_o_a, 'w_kv_shared': w_kv_shared,
            'w_q_b': w_q_b, 'w_o_b': w_o_b, 'sinks_b': sinks_b,
            'w_gate_d': w_gate_d, 'w_up_d': w_up_d, 'w_down_d': w_down_d,
            'w_router': w_router, 'w_gate_e': w_gate_e, 'w_up_e': w_up_e, 'w_down_e': w_down_e,
            'ln_gain': ln_gain, 'ln_bias': ln_bias}


def reference(x, w_qkv_a, w_o_a, w_kv_shared, w_q_b, w_o_b, sinks_b,
              w_gate_d, w_up_d, w_down_d, w_router, w_gate_e, w_up_e, w_down_e,
              ln_gain, ln_bias):
    B, T, _ = x.shape
    alpha = DEEPNORM_ALPHA
    k_sh = v_sh = None
    for i in range(DEPTH):
        if i < N_A:
            mix = moba_attention(x, w_qkv_a[i], w_o_a[i])
        else:
            if i == N_A:
                kv = (x @ w_kv_shared).reshape(B, T, 2, N_KV_B, HEAD_DIM)
                k_sh, v_sh = kv[:, :, 0], kv[:, :, 1]
            j = i - N_A
            mix = swa_sinks_attention(x, w_q_b[j], w_o_b[j], sinks_b[j], k_sh, v_sh)
        x = layer_norm(alpha * x + mix, ln_gain[i, 0], ln_bias[i, 0])
        if i % 2 == 0:
            ffn = swiglu(x, w_gate_d[i // 2], w_up_d[i // 2], w_down_d[i // 2])
        else:
            ffn = moe_swiglu(x, w_router[i // 2], w_gate_e[i // 2], w_up_e[i // 2], w_down_e[i // 2])
        x = layer_norm(alpha * x + ffn, ln_gain[i, 1], ln_bias[i, 1])
    return x
```

```cpp
#include <hip/hip_runtime.h>
#include <cstdio>
#include <cstdint>

namespace pg8 {
#define PG8_LAS __attribute__((address_space(3)))
typedef unsigned short bf16_t;
typedef short bf16x8 __attribute__((ext_vector_type(8)));
typedef float f32x4 __attribute__((ext_vector_type(4)));
typedef unsigned u32x4 __attribute__((ext_vector_type(4)));
typedef int i32x4 __attribute__((ext_vector_type(4))); typedef int i32x8 __attribute__((ext_vector_type(8)));
constexpr int BM = 256, BK = 64, HALF = 128, HTB = HALF * BK * 2  , STAGE_BYTES = 8 * HTB, NXCD = 8, WGM = 8;

__host__ __device__ __forceinline__ int lds_byte(int r, int c) { const int st = (r >> 4) * 2 + (c >> 5), rr = r & 15, cc = c & 31, ob = rr * 64 + cc * 2; return st * 1024 + (ob ^ (((ob >> 9) & 1) << 5)); }
__host__ __device__ __forceinline__ void stage_rc(int b, int& R, int& C) { const int st = b / 1024, sb = b % 1024, swz = sb ^ (((sb >> 9) & 1) << 5); R = (st >> 1) * 16 + swz / 64; C = (st & 1) * 32 + (swz % 64) / 2; }
__host__ __device__ __forceinline__ int perm32(int rho) { const int n = rho >> 4, i = rho & 15; return 8 * (i >> 2) + 4 * n + (i & 3); }

struct Unit { int pm, pn, ks; };
struct Gemm { const bf16_t* A; const bf16_t* Bt; int K, lda, ldb; };

struct StaticOrder {
    int nM, nN, nwg, G, c;
    __device__ __forceinline__ void init(int nM_, int nN_, int G_, int c_) { nM = nM_; nN = nN_; nwg = nM * nN; G = G_; c = c_; }
    __device__ __forceinline__ bool next(int i, Unit& u) const {
        const long L = (long)i * G + c; if (L >= nwg) return false;
        int wgid = (int)L; { const int q = nwg / NXCD, r = nwg % NXCD, xcd = wgid % NXCD, off = wgid / NXCD; wgid = (xcd < r ? xcd * (q + 1) : r * (q + 1) + (xcd - r) * q) + off; }
        const int nig = WGM * nN, gid = wgid / nig, fm = gid * WGM, gsz = (nM - fm) < WGM ? (nM - fm) : WGM;
        u.pm = fm + ((wgid % nig) % gsz); u.pn = (wgid % nig) / gsz; return true;
    }
    __device__ __forceinline__ size_t b_off(const Unit&) const { return 0; }
    __device__ __forceinline__ size_t a_off(const Unit&) const { return 0; }
    __device__ __forceinline__ void a_ready(const Unit&) const {}
    __device__ __forceinline__ void done(const Unit&) const {}
};
struct MoeOrder {
    StaticOrder so; const PG8_LAS int* texp; size_t estride; const int* rows;
    __device__ __forceinline__ bool next(int i, Unit& u) const { return so.next(i, u); }
    __device__ __forceinline__ size_t b_off(const Unit& u) const { return (size_t)texp[u.pm] * estride; }
    __device__ __forceinline__ size_t a_off(const Unit&) const { return 0; }
    __device__ __forceinline__ void a_ready(const Unit&) const {}
    __device__ __forceinline__ void done(const Unit&) const {}
};

struct SplitOrder {
    int total, G, c, tile0, nks; const PG8_LAS int* texp; size_t estride; int kslice; const int* rows;
    __device__ __forceinline__ bool next(int i, Unit& u) const { const int idx = i * G + c; if (idx >= total) return false; const int q = idx / nks; u.ks = idx - q * nks; u.pm = tile0 + (q >> 2); u.pn = q & 3; return true; }
    __device__ __forceinline__ size_t b_off(const Unit& u) const { return (size_t)texp[u.pm] * estride + (size_t)u.ks * kslice; }
    __device__ __forceinline__ size_t a_off(const Unit& u) const { return (size_t)u.ks * kslice; }
    __device__ __forceinline__ void a_ready(const Unit&) const {}
    __device__ __forceinline__ void done(const Unit&) const {}
};
__device__ __forceinline__ unsigned cvt_pk_bf16(float lo, float hi) { unsigned r; asm volatile("v_cvt_pk_bf16_f32 %0, %1, %2" : "=v"(r) : "v"(lo), "v"(hi)); return r; }

__device__ __forceinline__ unsigned pk4_i8(float a, float b, float c, float d) {
    const int ia = (int)__builtin_rintf(__builtin_amdgcn_fmed3f(a, -127.f, 127.f)), ib = (int)__builtin_rintf(__builtin_amdgcn_fmed3f(b, -127.f, 127.f)), ic = (int)__builtin_rintf(__builtin_amdgcn_fmed3f(c, -127.f, 127.f)), id = (int)__builtin_rintf(__builtin_amdgcn_fmed3f(d, -127.f, 127.f));
    return ((unsigned)ia & 255u) | (((unsigned)ib & 255u) << 8) | (((unsigned)ic & 255u) << 16) | ((unsigned)id << 24); }
__device__ __forceinline__ f32x4 acc_i2f(f32x4 a) { const i32x4 i = __builtin_bit_cast(i32x4, a); return (f32x4){(float)i[0], (float)i[1], (float)i[2], (float)i[3]}; }
struct EpiBf16 {
    static constexpr bool PERM = true;
    bf16_t* O; int ldc; int split_cols; size_t split_stride; float scale0; float* kmean;
    __device__ __forceinline__ void operator()(const f32x4 (&acc)[2][2][4][2], const Unit& u, int wr, int wc, int fr, int fq) const {
        const int row0 = u.pm * BM + wr * 64 + fr; int colt = u.pn * BM; bf16_t* base = O;
        float sc = scale0; int tsel = 0; if (split_cols) { const int t = colt / split_cols; tsel = t; base += (size_t)t * split_stride; colt -= t * split_cols; if (t != 0) sc = 1.f; }
        const int col0 = colt + wc * 32 + 8 * fq;
        if (kmean != nullptr && tsel == 1) {
#pragma unroll
            for (int bj = 0; bj < 2; ++bj)
#pragma unroll
                for (int n = 0; n < 2; ++n) { f32x4 s = (f32x4){0.f, 0.f, 0.f, 0.f};
#pragma unroll
                    for (int ai = 0; ai < 2; ++ai)
#pragma unroll
                        for (int m = 0; m < 4; ++m) s += acc[ai][bj][m][n];
#pragma unroll
                    for (int j = 0; j < 4; ++j) { float v = s[j]; v += __shfl_xor(v, 1); v += __shfl_xor(v, 2); v += __shfl_xor(v, 4); v += __shfl_xor(v, 8);
                        if (fr == 0) { const int c = col0 + bj * HALF + 4 * n + j; atomicAdd(kmean + ((size_t)((u.pm >> 4) * 16 + (c >> 6)) * 16 + (u.pm & 15)) * 64 + (c & 63), v * (1.f / 256.f)); } } }
            asm volatile("" ::: "memory");
        }
#pragma unroll
        for (int ai = 0; ai < 2; ++ai)
#pragma unroll
            for (int m = 0; m < 4; ++m) { bf16_t* rowp = base + (size_t)(row0 + ai * HALF + m * 16) * ldc + col0;
#pragma unroll
                for (int bj = 0; bj < 2; ++bj) { f32x4 v0 = acc[ai][bj][m][0] * sc, v1 = acc[ai][bj][m][1] * sc;
                    u32x4 w; w.x = cvt_pk_bf16(v0[0], v0[1]); w.y = cvt_pk_bf16(v0[2], v0[3]); w.z = cvt_pk_bf16(v1[0], v1[1]); w.w = cvt_pk_bf16(v1[2], v1[3]);
                    *(u32x4*)(rowp + bj * HALF) = w; } }
    }
};
__device__ __forceinline__ float silu_mul_raw(float ga, float uc, float c1) { const float e = __builtin_amdgcn_exp2f(ga * c1); return (ga * __builtin_amdgcn_rcpf(1.0f + e)) * uc; }
__device__ __forceinline__ unsigned pk4_fp8(float a, float b, float c, float d) { int r = 0; r = __builtin_amdgcn_cvt_pk_fp8_f32(a, b, r, false); r = __builtin_amdgcn_cvt_pk_fp8_f32(c, d, r, true); return (unsigned)r; }
__device__ __forceinline__ float clamp448(float v) { return __builtin_amdgcn_fmed3f(v, -448.f, 448.f); }
template <bool ISINT> struct EpiSwigluF8 {
    static constexpr bool PERM = true;
    unsigned char* H; int ldh; float sc, hs;
    __device__ __forceinline__ void operator()(const f32x4 (&acc)[2][2][4][2], const Unit& u, int wr, int wc, int fr, int fq) const {
        const int row0 = u.pm * BM + wr * 64 + fr; const int col0 = u.pn * HALF + wc * 32 + 8 * fq;
        typedef unsigned u32x2 __attribute__((ext_vector_type(2)));
#pragma unroll
        for (int ai = 0; ai < 2; ++ai)
#pragma unroll
            for (int m = 0; m < 4; ++m) { unsigned char* rowp = H + (size_t)(row0 + ai * HALF + m * 16) * ldh + col0;
                const float c1 = -1.4426950408889634f * sc, c2 = sc * sc * hs;
                const f32x4 g0 = (ISINT ? acc_i2f(acc[ai][0][m][0]) : acc[ai][0][m][0]), g1 = (ISINT ? acc_i2f(acc[ai][0][m][1]) : acc[ai][0][m][1]), u0 = (ISINT ? acc_i2f(acc[ai][1][m][0]) : acc[ai][1][m][0]) * c2, u1 = (ISINT ? acc_i2f(acc[ai][1][m][1]) : acc[ai][1][m][1]) * c2;
                u32x2 w; w.x = pk4_fp8(clamp448(silu_mul_raw(g0[0], u0[0], c1)), clamp448(silu_mul_raw(g0[1], u0[1], c1)), clamp448(silu_mul_raw(g0[2], u0[2], c1)), clamp448(silu_mul_raw(g0[3], u0[3], c1)));
                w.y = pk4_fp8(clamp448(silu_mul_raw(g1[0], u1[0], c1)), clamp448(silu_mul_raw(g1[1], u1[1], c1)), clamp448(silu_mul_raw(g1[2], u1[2], c1)), clamp448(silu_mul_raw(g1[3], u1[3], c1)));
                *(u32x2*)rowp = w; }
    }
};
struct EpiMoeDown {
    static constexpr bool PERM = true;
    bf16_t* Y; const int* rowpair; const float* roww; float sc;
    __device__ __forceinline__ void operator()(const f32x4 (&acc)[2][2][4][2], const Unit& u, int wr, int wc, int fr, int fq) const {
        const int row0 = u.pm * BM + wr * 64 + fr; const int col0 = u.pn * BM + wc * 32 + 8 * fq;
        int pid[2][4]; float w[2][4];
#pragma unroll
        for (int ai = 0; ai < 2; ++ai)
#pragma unroll
            for (int m = 0; m < 4; ++m) { pid[ai][m] = rowpair[row0 + ai * HALF + m * 16]; w[ai][m] = roww[row0 + ai * HALF + m * 16] * sc; }
#pragma unroll
        for (int ai = 0; ai < 2; ++ai)
#pragma unroll
            for (int m = 0; m < 4; ++m) {
                if (pid[ai][m] >= 0) { bf16_t* rowp = Y + (size_t)pid[ai][m] * 1024 + col0;
#pragma unroll
                    for (int bj = 0; bj < 2; ++bj) { const f32x4 v0 = acc[ai][bj][m][0] * w[ai][m], v1 = acc[ai][bj][m][1] * w[ai][m];
                        u32x4 wv; wv.x = cvt_pk_bf16(v0[0], v0[1]); wv.y = cvt_pk_bf16(v0[2], v0[3]); wv.z = cvt_pk_bf16(v1[0], v1[1]); wv.w = cvt_pk_bf16(v1[2], v1[3]);
                        *(u32x4*)(rowp + bj * HALF) = wv; } } }
    }
};

struct EpiPartial {
    static constexpr bool PERM = false;
    float* P; const float* roww; float sc; int tile0, prow;
    __device__ __forceinline__ void operator()(const f32x4 (&acc)[2][2][4][2], const Unit& u, int wr, int wc, int fr, int fq) const {
        const int col0 = u.pn * BM + wc * 32 + 4 * fq;
#pragma unroll
        for (int ai = 0; ai < 2; ++ai)
#pragma unroll
            for (int m = 0; m < 4; ++m) { const int rl = ai * HALF + wr * 64 + m * 16 + fr; const float w = roww[u.pm * BM + rl] * sc;
                float* rp = P + ((size_t)u.ks * prow + (size_t)(u.pm - tile0) * BM + rl) * 1024 + col0;
#pragma unroll
                for (int bj = 0; bj < 2; ++bj)
#pragma unroll
                    for (int n = 0; n < 2; ++n) *(f32x4*)(rp + bj * HALF + n * 16) = acc[ai][bj][m][n] * w; }
    }
};

template <class Epi, class Sched, bool ALIGN_EPI, bool GATHER, int QT = 0>
__device__ __forceinline__ void gemm_phase(PG8_LAS unsigned char* lds, const Gemm g, const Sched& S, const Epi& E) {
    const int tid = threadIdx.x, wid = __builtin_amdgcn_readfirstlane(tid >> 6), lane = tid & 63, wr = wid >> 2, wc = wid & 3, fr = lane & 15, fq = lane >> 4;
    constexpr bool F8 = (QT == 1), I8 = (QT == 2), H16 = (QT == 3); constexpr int ESZ = (QT == 1 || QT == 2) ? 1 : 2;
    const int K = g.K, nt = K * ESZ / (BK * 2);
    unsigned voffB[2], vA0[2], vA1[2], vA0n[2], vA1n[2]; int Rr[2], Cc[2];
#pragma unroll
    for (int i = 0; i < 2; ++i) { int R, C; stage_rc(tid * 16 + i * 8192, R, C); const int Rb = Epi::PERM ? ((R & ~31) + perm32(R & 31)) : R; Rr[i] = R; Cc[i] = C;
        voffB[i] = (unsigned)(Rb * g.ldb) * ESZ + 2u * C; vA0[i] = (unsigned)(R * g.lda) * ESZ + 2u * C; vA1[i] = (unsigned)((R + HALF) * g.lda) * ESZ + 2u * C; vA0n[i] = vA0[i]; vA1n[i] = vA1[i]; }
    const size_t kstep = (size_t)(BK * 2);
    const size_t hstepB = (size_t)HALF * g.ldb * ESZ, tstepB = 2 * hstepB, tstepA = (size_t)BM * g.lda * ESZ;
    const unsigned ldsw = (unsigned)wid * 1024u;
    const int aoff = lds_byte(wr * 64 + fr, fq * 8), boff = lds_byte(wc * 32 + fr, fq * 8);
#define PG8_SA(b, h) (((b) * 2 + (h)) * HTB)
#define PG8_SB(b, h) ((4 + (b) * 2 + (h)) * HTB)
#define PG8_STAGE(bufoff, gbase, voff) do { _Pragma("unroll") for (int _i = 0; _i < 2; ++_i) \
        __builtin_amdgcn_global_load_lds((const unsigned*)((const char*)(gbase) + (voff)[_i]), (PG8_LAS unsigned*)(lds + (bufoff) + ldsw + _i * 8192), 16, 0, 0); } while (0)
#define PG8_LDA(dst, b, h) do { _Pragma("unroll") for (int m = 0; m < 4; ++m) { const i32x4 f0_ = *(const PG8_LAS i32x4*)(lds + PG8_SA(b, h) + aoff + m * 2048), f1_ = *(const PG8_LAS i32x4*)(lds + PG8_SA(b, h) + aoff + m * 2048 + 1024); \
        dst[m] = __builtin_shufflevector(f0_, f1_, 0, 1, 2, 3, 4, 5, 6, 7); } } while (0)
#define PG8_LDB(dst, b, h) do { _Pragma("unroll") for (int n = 0; n < 2; ++n) { const i32x4 f0_ = *(const PG8_LAS i32x4*)(lds + PG8_SB(b, h) + boff + n * 2048), f1_ = *(const PG8_LAS i32x4*)(lds + PG8_SB(b, h) + boff + n * 2048 + 1024); \
        dst[n] = __builtin_shufflevector(f0_, f1_, 0, 1, 2, 3, 4, 5, 6, 7); } } while (0)
#define PG8_LO4(v) ((i32x4)__builtin_shufflevector(v, v, 0, 1, 2, 3))
#define PG8_HI4(v) ((i32x4)__builtin_shufflevector(v, v, 4, 5, 6, 7))
#define PG8_MMA(ai, bj, At, Bt) do { __builtin_amdgcn_s_setprio(1); _Pragma("unroll") for (int n = 0; n < 2; ++n) _Pragma("unroll") for (int m = 0; m < 4; ++m) { \
        if constexpr (F8) asm volatile("v_mfma_scale_f32_16x16x128_f8f6f4 %0, %1, %2, %0, %3, %3 op_sel_hi:[0,0,0]" : "+v"(acc[ai][bj][m][n]) : "v"(Bt[n]), "v"(At[m]), "v"(scl1));   \
        else if constexpr (I8) { asm volatile("v_mfma_i32_16x16x64_i8 %0, %1, %2, %0" : "+v"(acc[ai][bj][m][n]) : "v"(PG8_LO4(Bt[n])), "v"(PG8_LO4(At[m]))); asm volatile("v_mfma_i32_16x16x64_i8 %0, %1, %2, %0" : "+v"(acc[ai][bj][m][n]) : "v"(PG8_HI4(Bt[n])), "v"(PG8_HI4(At[m]))); } \
        else if constexpr (H16) { asm volatile("v_mfma_f32_16x16x32_f16 %0, %1, %2, %0" : "+v"(acc[ai][bj][m][n]) : "v"(PG8_LO4(Bt[n])), "v"(PG8_LO4(At[m]))); asm volatile("v_mfma_f32_16x16x32_f16 %0, %1, %2, %0" : "+v"(acc[ai][bj][m][n]) : "v"(PG8_HI4(Bt[n])), "v"(PG8_HI4(At[m]))); } \
        else { asm volatile("v_mfma_f32_16x16x32_bf16 %0, %1, %2, %0" : "+v"(acc[ai][bj][m][n]) : "v"(PG8_LO4(Bt[n])), "v"(PG8_LO4(At[m]))); asm volatile("v_mfma_f32_16x16x32_bf16 %0, %1, %2, %0" : "+v"(acc[ai][bj][m][n]) : "v"(PG8_HI4(Bt[n])), "v"(PG8_HI4(At[m]))); } } __builtin_amdgcn_s_setprio(0); } while (0)
#define PG8_WAIT_V(n) asm volatile("s_waitcnt vmcnt(" #n ")" ::: "memory")
#define PG8_WAIT_L(n) asm volatile("s_waitcnt lgkmcnt(" #n ")" ::: "memory")
#define PG8_BAR __builtin_amdgcn_s_barrier()
#define PG8_SCHED __builtin_amdgcn_sched_barrier(0)
#define PG8_GROWS(u, v0, v1) do { const int* rp_ = S.rows + (size_t)(u).pm * BM; _Pragma("unroll") for (int i_ = 0; i_ < 2; ++i_) { \
        const unsigned r0_ = (unsigned)rp_[Rr[i_]], r1_ = (unsigned)rp_[HALF + Rr[i_]]; v0[i_] = r0_ * (unsigned)g.lda * ESZ + 2u * (unsigned)Cc[i_]; v1[i_] = r1_ * (unsigned)g.lda * ESZ + 2u * (unsigned)Cc[i_]; \
        asm volatile("" : "+v"(v0[i_]), "+v"(v1[i_])); } } while (0)
    Unit cur, nxt; int ui = 0;
    if (!S.next(0, cur)) return;
    f32x4 acc[2][2][4][2];
#pragma unroll
    for (int a = 0; a < 2; ++a)
#pragma unroll
        for (int b = 0; b < 2; ++b)
#pragma unroll
            for (int m = 0; m < 4; ++m)
#pragma unroll
                for (int n = 0; n < 2; ++n) acc[a][b][m][n] = (f32x4){0.f, 0.f, 0.f, 0.f};
    i32x8 At[4], B0[2], B1[2]; int scl1 = 0x7f7f7f7f; asm volatile("" : "+v"(scl1));
    const char* cA = (const char*)g.A + (GATHER ? (size_t)0 : (size_t)cur.pm * tstepA) + S.a_off(cur); const char* cB = (const char*)g.Bt + S.b_off(cur) + (size_t)cur.pn * tstepB;
    if constexpr (GATHER) { PG8_GROWS(cur, vA0, vA1); }
    S.a_ready(cur);
    PG8_STAGE(PG8_SB(0, 0), cB, voffB); PG8_STAGE(PG8_SB(0, 1), cB + hstepB, voffB); PG8_STAGE(PG8_SA(0, 0), cA, vA0); PG8_STAGE(PG8_SA(0, 1), cA, vA1);
    if (wr == 1) PG8_BAR;
    PG8_WAIT_V(2); PG8_BAR;
    PG8_STAGE(PG8_SB(1, 0), cB + kstep, voffB); PG8_STAGE(PG8_SA(1, 0), cA + kstep, vA0); PG8_STAGE(PG8_SB(1, 1), cB + hstepB + kstep, voffB);
    PG8_WAIT_V(6); PG8_BAR;
    for (;;) {
        const bool has_next = S.next(ui + 1, nxt);
        const char* nA = (has_next && !GATHER) ? (const char*)g.A + (size_t)nxt.pm * tstepA + S.a_off(nxt) : cA; const char* nB = has_next ? (const char*)g.Bt + S.b_off(nxt) + (size_t)nxt.pn * tstepB : cB;
        if constexpr (GATHER) { if (has_next) { PG8_GROWS(nxt, vA0n, vA1n); } else {
#pragma unroll
            for (int i = 0; i < 2; ++i) { vA0n[i] = vA0[i]; vA1n[i] = vA1[i]; } } }
#define PG8_PTRS(t) const bool last = ((t) == nt - 2); const char* a1 = cA + (size_t)((t) + 1) * kstep; \
            const char* a2 = last ? nA : cA + (size_t)((t) + 2) * kstep; const char* b2 = last ? nB : cB + (size_t)((t) + 2) * kstep; \
            const char* a3 = a2 + kstep; const char* b3 = b2 + kstep; unsigned x0[2], x1[2]; \
            _Pragma("unroll") for (int i = 0; i < 2; ++i) { x0[i] = (GATHER && last) ? vA0n[i] : vA0[i]; x1[i] = (GATHER && last) ? vA1n[i] : vA1[i]; }
#define PG8_TRIP(WV, STG1) do { \
            PG8_LDB(B0, 0, 0); PG8_LDB(B1, 0, 1); PG8_SCHED; PG8_LDA(At, 0, 0); if (STG1) { PG8_STAGE(PG8_SA(1, 1), a1, vA1); } \
            PG8_WAIT_V(WV); PG8_WAIT_L(0); PG8_BAR; PG8_MMA(0, 0, At, B0); PG8_MMA(0, 1, At, B1); PG8_BAR; PG8_SCHED; \
            PG8_LDA(At, 0, 1); PG8_STAGE(PG8_SB(0, 0), b2, voffB); PG8_STAGE(PG8_SB(0, 1), b2 + hstepB, voffB); PG8_STAGE(PG8_SA(0, 0), a2, x0); \
            PG8_WAIT_V(WV); PG8_WAIT_L(0); PG8_BAR; PG8_MMA(1, 0, At, B0); PG8_MMA(1, 1, At, B1); PG8_BAR; PG8_SCHED; \
            PG8_LDB(B0, 1, 0); PG8_LDB(B1, 1, 1); PG8_SCHED; PG8_LDA(At, 1, 0); PG8_STAGE(PG8_SA(0, 1), a2, x1); \
            PG8_WAIT_V(WV); PG8_WAIT_L(0); PG8_BAR; PG8_MMA(0, 0, At, B0); PG8_MMA(0, 1, At, B1); PG8_BAR; PG8_SCHED; \
            PG8_LDA(At, 1, 1); PG8_STAGE(PG8_SB(1, 0), b3, voffB); PG8_STAGE(PG8_SB(1, 1), b3 + hstepB, voffB); PG8_STAGE(PG8_SA(1, 0), a3, x0); \
            PG8_WAIT_V(8); PG8_WAIT_L(0); PG8_BAR; PG8_MMA(1, 0, At, B0); PG8_MMA(1, 1, At, B1); PG8_BAR; PG8_SCHED; } while (0)
        for (int t = 0; t < nt; t += 2) { PG8_PTRS(t) PG8_TRIP(8, true); }
#undef PG8_TRIP
#undef PG8_PTRS
        if constexpr (ALIGN_EPI) { if (wr == 0) PG8_BAR; }
        asm volatile("s_nop 15\n\ts_nop 7" ::: "memory");
        E(acc, cur, wr, wc, fr, fq); S.done(cur);
        if (!has_next) break;
#pragma unroll
        for (int a = 0; a < 2; ++a)
#pragma unroll
            for (int b = 0; b < 2; ++b)
#pragma unroll
                for (int m = 0; m < 4; ++m)
#pragma unroll
                    for (int n = 0; n < 2; ++n) acc[a][b][m][n] = (f32x4){0.f, 0.f, 0.f, 0.f};
        cur = nxt; cA = nA; cB = nB; ++ui;
        if constexpr (GATHER) {
#pragma unroll
            for (int i = 0; i < 2; ++i) { vA0[i] = vA0n[i]; vA1[i] = vA1n[i]; } }
        if constexpr (ALIGN_EPI) { if (wr == 1) PG8_BAR; }
    }
    PG8_WAIT_V(0);
    if constexpr (!ALIGN_EPI) { if (wr == 0) PG8_BAR; }
    PG8_BAR;
#undef PG8_SA
#undef PG8_SB
#undef PG8_STAGE
#undef PG8_LDA
#undef PG8_LDB
#undef PG8_MMA
#undef PG8_WAIT_V
#undef PG8_WAIT_L
#undef PG8_BAR
#undef PG8_SCHED
#undef PG8_GROWS
#undef PG8_LO4
#undef PG8_HI4
}
}

constexpr int NWAVES = 8;
constexpr int BATCH = 8, SEQ = 4096, D = 1024, NH = 16, HD = 64, T = BATCH * SEQ;
constexpr int FFD = 2816, FFE = 3584, NE = 8;
constexpr int MB = 256, NBLK = SEQ / MB;
constexpr int SW = 128;
constexpr float LN_EPS = 1e-5f;
constexpr float ALPHA = 1.4142135623730951f;
constexpr float LOG2E = 1.4426950408889634f;
constexpr float C2 = 0.125f * LOG2E;
constexpr float XSC = 20.f, WSC_GU = 1280.f, HSC = 32.f, WSC_D = 2048.f;
constexpr int MAXTILES = 264;
constexpr int MAXROWS = MAXTILES * 256;

constexpr size_t MiB = 1u << 20, KiB = 1u << 10;
constexpr size_t WS_CTL = 0, CTL_ZERO_BYTES = 64 * 1024;
constexpr size_t WS_ROUTE = 1 * MiB;
constexpr size_t WS_WQKV = 2 * MiB, WS_WOA = 8 * MiB, WS_WGUD = 10 * MiB, WS_WDD = 21 * MiB, WS_WQB = 27 * MiB, WS_WOB = 30 * MiB;
constexpr size_t WS_WGUE = 32 * MiB;
constexpr size_t WS_WDE = 88 * MiB;
constexpr size_t WS_XB = 200 * MiB;
constexpr size_t WS_Q = 264 * MiB, WS_K = 328 * MiB, WS_V = 392 * MiB;
constexpr size_t WS_H = 264 * MiB;
constexpr size_t WS_X8 = 116 * MiB;
constexpr size_t WS_KMEAN = 496 * MiB;
constexpr size_t WS_END = 500 * MiB;
static_assert(WS_WQKV + (size_t)3 * D * D * 2 <= WS_WOA && WS_WOA + (size_t)D * D * 2 <= WS_WGUD && WS_WGUD + (size_t)2 * FFD * D * 2 <= WS_WDD && WS_WDD + (size_t)FFD * D * 2 <= WS_WQB &&
              WS_WQB + (size_t)1280 * D * 2 <= WS_WOB && WS_WOB + (size_t)D * D * 2 <= WS_WGUE && WS_WGUE + (size_t)NE * 2 * FFE * D <= WS_WDE && WS_WDE + (size_t)NE * FFE * D <= WS_X8 && WS_X8 + (size_t)T * D <= WS_XB, "weights map");
static_assert(WS_H + (size_t)MAXROWS * FFE <= WS_KMEAN && WS_H + (size_t)T * FFD * 2 <= WS_KMEAN, "h map");
constexpr size_t R_ROWTOK = WS_ROUTE + 0;
constexpr size_t R_ROWPAIR = WS_ROUTE + 272 * KiB;
constexpr size_t R_ROWW = WS_ROUTE + 544 * KiB;
constexpr size_t R_RE = WS_ROUTE + 816 * KiB;
constexpr size_t R_CNT = WS_ROUTE + 944 * KiB;
constexpr size_t R_RWF = WS_KMEAN + 640 * KiB;
constexpr size_t R_PPOS = WS_KMEAN + 896 * KiB;
constexpr int MAINTILES = 256, LEFTTILES = MAXTILES - MAINTILES, NKS = 7, KSLICE = FFE / NKS;
constexpr size_t WS_PART = WS_X8;
static_assert(WS_PART + (size_t)NKS * LEFTTILES * 256 * 1024 * 4 <= WS_XB && R_PPOS + (size_t)2 * T * 4 <= WS_END && KSLICE % 256 == 0, "split-K partials map");
static_assert((size_t)MAXROWS * 4 <= 272 * KiB && R_CNT + 8 * KiB <= 2 * MiB && R_RWF + (size_t)T * 8 <= WS_END, "route map");

constexpr int RING_BYTES = 131072;
constexpr int MISC_OFF = RING_BYTES;
constexpr int LDS_BYTES = 147456;
constexpr int MW_BAR = 0;
constexpr int MW_START = 16;
constexpr int MW_TOTAL = 32;
constexpr int MW_NTILES = 48;
constexpr int MW_CBASE = 52;
constexpr int MW_TEXP = 64;
constexpr int MW_CNT = 512;
constexpr int MW_SPAIR = 2560;
static_assert(MW_SPAIR + 256 <= 4096 && MW_TEXP + MAXTILES <= MW_CNT, "MISC map");

#define GAS __attribute__((address_space(1)))
#define LAS __attribute__((address_space(3)))
typedef unsigned short bf16;
typedef unsigned v4u __attribute__((ext_vector_type(4)));
typedef float f32x4 __attribute__((ext_vector_type(4)));
typedef GAS unsigned gu32;
#define RLX_AGENT __ATOMIC_RELAXED, __HIP_MEMORY_SCOPE_AGENT
#define LDS_WAIT() asm volatile("s_waitcnt lgkmcnt(0)" ::: "memory")
#define VM_WAIT() asm volatile("s_waitcnt vmcnt(0)" ::: "memory")
__device__ __forceinline__ unsigned f2bf(float f) { unsigned u = __builtin_bit_cast(unsigned, f); return (u + 0x7fffu + ((u >> 16) & 1u)) >> 16; }
__device__ __forceinline__ unsigned pk2(float lo, float hi) { return f2bf(lo) | (f2bf(hi) << 16); }
typedef _Float16 h16x2 __attribute__((ext_vector_type(2)));
__device__ __forceinline__ unsigned pkh2(float lo, float hi) { const h16x2 v = {(_Float16)lo, (_Float16)hi}; return __builtin_bit_cast(unsigned, v); }
__device__ __forceinline__ float hlo(unsigned w) { return (float)__builtin_bit_cast(h16x2, w)[0]; }
__device__ __forceinline__ float hhi(unsigned w) { return (float)__builtin_bit_cast(h16x2, w)[1]; }
__device__ __forceinline__ float bflo(unsigned w) { return __uint_as_float(w << 16); }
__device__ __forceinline__ float bfhi(unsigned w) { return __uint_as_float(w & 0xffff0000u); }

#define XB_TMO      128
#define XB_XCNT(j)  (256  + 64 * (j))
#define XB_XSUB(j)  (1280 + 64 * (j))
#define XB_XGEN(j)  (2304 + 64 * (j))
#define XB_TOP      3328
#define XB_TOPGEN   3392
#define XCD_BAR_WORDS 3456
#define XB_SPIN_CAP (1u << 22)
__device__ __forceinline__ unsigned xb_ld(unsigned* p)              { return __hip_atomic_load(p, __ATOMIC_RELAXED, __HIP_MEMORY_SCOPE_AGENT); }
__device__ __forceinline__ unsigned xb_add(unsigned* p, unsigned v) { return __hip_atomic_fetch_add(p, v, __ATOMIC_RELAXED, __HIP_MEMORY_SCOPE_AGENT); }
__device__ __forceinline__ unsigned xb_xcc_id() { return (unsigned)__builtin_amdgcn_s_getreg((3 << 11) | 20) & 0xFu; }
#define XB_SPIN(cond, bar) do { unsigned _sp = 0; while (cond) { __builtin_amdgcn_s_sleep(1); \
    if ((++_sp & 255u) == 0u) { if (xb_ld(&(bar)[XB_TMO])) break; if (_sp > XB_SPIN_CAP) { atomicAdd(&(bar)[XB_TMO], 1u); break; } } } } while (0)
struct XcdBarrier { unsigned* bar; unsigned x; volatile LAS unsigned* st; };
__device__ __forceinline__ XcdBarrier xcd_barrier_post(unsigned* bar, volatile LAS unsigned* st) {
    XcdBarrier b; b.bar = bar; b.x = xb_xcc_id(); b.st = st;
    if (threadIdx.x == 0) (void)xb_add(&bar[XB_XCNT(b.x)], 1u);
    return b;
}
__device__ __forceinline__ void xcd_barrier_complete(unsigned* bar, unsigned x, unsigned& nloc, unsigned& nx) {
    const unsigned G = gridDim.x * gridDim.y * gridDim.z;
    unsigned sum, cnt, mine, sp = 0u;
    for (;;) {
        sum = 0u; cnt = 0u; mine = 0u;
#pragma unroll
        for (unsigned j = 0; j < 16; ++j) { const unsigned c = xb_ld(&bar[XB_XCNT(j)]); sum += c; cnt += (c > 0u) ? 1u : 0u; mine = (j == x) ? c : mine; }
        if (sum == G) break;
        __builtin_amdgcn_s_sleep(1);
        if ((++sp & 255u) == 0u) { if (xb_ld(&bar[XB_TMO])) break; if (sp > XB_SPIN_CAP) { atomicAdd(&bar[XB_TMO], 1u); break; } }
    }
    nloc = mine > 0u ? mine : 1u; nx = cnt > 0u ? cnt : 1u;
}
__device__ __forceinline__ void xcd_barrier(const XcdBarrier& b) {
    asm volatile("s_waitcnt vmcnt(0)" ::: "memory");
    __syncthreads();
    if (threadIdx.x == 0) {
        unsigned* bar = b.bar;
        __builtin_amdgcn_s_waitcnt(0);
        unsigned nloc = b.st[0], nx = b.st[1];
        if (nloc == 0u) { xcd_barrier_complete(bar, b.x, nloc, nx); b.st[0] = nloc; b.st[1] = nx; }
        const unsigned old = xb_add(&bar[XB_XSUB(b.x)], 1u);
        const unsigned gen = old / nloc;
        if (old + 1u == (gen + 1u) * nloc) {
            __builtin_amdgcn_fence(__ATOMIC_RELEASE, "agent");
            asm volatile("s_waitcnt vmcnt(0)" ::: "memory");
            const unsigned og = xb_add(&bar[XB_TOP], 1u);
            const unsigned tg = og / nx;
            if (og + 1u == (tg + 1u) * nx) xb_add(&bar[XB_TOPGEN], 1u);
            else XB_SPIN(xb_ld(&bar[XB_TOPGEN]) == tg, bar);
            __builtin_amdgcn_fence(__ATOMIC_ACQUIRE, "agent");
            xb_add(&bar[XB_XGEN(b.x)], 1u);
            asm volatile("s_waitcnt vmcnt(0)" ::: "memory");
        } else {
            XB_SPIN(xb_ld(&bar[XB_XGEN(b.x)]) == gen, bar);
            __builtin_amdgcn_fence(__ATOMIC_ACQUIRE, "agent");
            asm volatile("s_waitcnt vmcnt(0)" ::: "memory");
        }
    }
    __syncthreads();
}

struct Frame {
    LAS unsigned char* lds;
    volatile LAS unsigned* MISC;
    gu32* ctl;
    unsigned char* ws;
    int tid, lane, wave, G;
};
constexpr int CW_BAR = 1024;
static_assert((CW_BAR + XCD_BAR_WORDS) * 4 <= (int)CTL_ZERO_BYTES, "CTL words inside the memset region");

__device__ __forceinline__ float wave_sum(float v) {
#pragma unroll
    for (int o = 1; o < 64; o <<= 1) v += __shfl_xor(v, o);
    return v;
}
template <bool H16 = false> __device__ __forceinline__ void tr_item(const float* W, int ldw, int k0, int n0, bf16* dst, int ldt, LAS float* scr, int lane) {
#pragma unroll 8
    for (int i = 0; i < 32; ++i) { const int kk = 2 * i + (lane >> 5); scr[kk * 33 + (lane & 31)] = W[(size_t)(k0 + kk) * ldw + n0 + (lane & 31)]; }
    LDS_WAIT(); asm volatile("" ::: "memory");
    const int c = lane & 7;
#pragma unroll
    for (int j = 0; j < 4; ++j) { const int n = (lane >> 3) + 8 * j; const LAS float* s = scr + (8 * c) * 33 + n;
        v4u o; if (H16) { o.x = pkh2(s[0 * 33], s[1 * 33]); o.y = pkh2(s[2 * 33], s[3 * 33]); o.z = pkh2(s[4 * 33], s[5 * 33]); o.w = pkh2(s[6 * 33], s[7 * 33]); }
        else { o.x = pk2(s[0 * 33], s[1 * 33]); o.y = pk2(s[2 * 33], s[3 * 33]); o.z = pk2(s[4 * 33], s[5 * 33]); o.w = pk2(s[6 * 33], s[7 * 33]); }
        *(GAS v4u*)(dst + (size_t)n * ldt + 8 * c) = o; }
    LDS_WAIT(); asm volatile("" ::: "memory");
}
template <bool I8> __device__ __forceinline__ void tr_item8(const float* W, int ldw, int k0, int n0, unsigned char* dst, int ldt, float scale, LAS float* scr, int lane) {
#pragma unroll 8
    for (int i = 0; i < 32; ++i) { const int kk = 2 * i + (lane >> 5); scr[kk * 33 + (lane & 31)] = W[(size_t)(k0 + kk) * ldw + n0 + (lane & 31)]; }
    LDS_WAIT(); asm volatile("" ::: "memory");
    const int c = lane & 7; typedef unsigned u32x2 __attribute__((ext_vector_type(2)));
#pragma unroll
    for (int j = 0; j < 4; ++j) { const int n = (lane >> 3) + 8 * j; const LAS float* s = scr + (8 * c) * 33 + n;
        u32x2 o; if (I8) { o.x = pg8::pk4_i8(s[0 * 33] * scale, s[1 * 33] * scale, s[2 * 33] * scale, s[3 * 33] * scale); o.y = pg8::pk4_i8(s[4 * 33] * scale, s[5 * 33] * scale, s[6 * 33] * scale, s[7 * 33] * scale); }
        else { o.x = pg8::pk4_fp8(s[0 * 33] * scale, s[1 * 33] * scale, s[2 * 33] * scale, s[3 * 33] * scale); o.y = pg8::pk4_fp8(s[4 * 33] * scale, s[5 * 33] * scale, s[6 * 33] * scale, s[7 * 33] * scale); }
        *(GAS u32x2*)(dst + (size_t)n * ldt + 8 * c) = o; }
    LDS_WAIT(); asm volatile("" ::: "memory");
}
template <bool I8> __device__ __forceinline__ void tr_job8(const float* W, int K, int N, unsigned char* WT, int ldt, int mode, float scale, LAS float* scr, int r, int lane) {
    const int nblk = N / 32, kb = r / nblk, nb = r % nblk, k0 = 64 * kb, n0 = 32 * nb;
    const int row = (mode == 0) ? n0 : ((n0 >> 7) * 256 + (mode - 1) * 128 + (n0 & 127));
    tr_item8<I8>(W, N, k0, n0, WT + (size_t)row * ldt + k0, ldt, scale, scr, lane);
}
template <bool H16 = false> __device__ __forceinline__ void tr_job(const float* W, int K, int N, bf16* WT, int ldt, int mode, int row_off, LAS float* scr, int r, int lane) {
    const int nblk = N / 32, kb = r / nblk, nb = r % nblk, k0 = 64 * kb, n0 = 32 * nb;
    const int row = (mode == 0) ? (row_off + n0) : ((n0 >> 7) * 256 + (mode - 1) * 128 + (n0 & 127));
    tr_item<H16>(W, N, k0, n0, WT + (size_t)row * ldt + k0, ldt, scr, lane);
}

struct Args { const float* in[16]; float* out; unsigned char* ws; int ph_lo, ph_hi; };

struct LnPar { f32x4 g[4], b[4]; };
__device__ __forceinline__ void ln_load_par(LnPar& P, const float* gain, const float* bias, int lane) {
#pragma unroll
    for (int j = 0; j < 4; ++j) { P.g[j] = *(const f32x4*)(gain + 256 * j + 4 * lane); P.b[j] = *(const f32x4*)(bias + 256 * j + 4 * lane); }
}
__device__ __forceinline__ void ln_row(f32x4 (&v)[4], const LnPar& P) {
    float s = 0.f;
#pragma unroll
    for (int j = 0; j < 4; ++j) s += (v[j].x + v[j].y) + (v[j].z + v[j].w);
    const float mean = wave_sum(s) * (1.f / D); float s2 = 0.f;
#pragma unroll
    for (int j = 0; j < 4; ++j) { v[j] = v[j] - mean; s2 += (v[j].x * v[j].x + v[j].y * v[j].y) + (v[j].z * v[j].z + v[j].w * v[j].w); }
    const float rstd = 1.f / sqrtf(wave_sum(s2) * (1.f / D) + LN_EPS);
#pragma unroll
    for (int j = 0; j < 4; ++j) v[j] = v[j] * rstd * P.g[j] + P.b[j];
}
__device__ __forceinline__ void route_tables(Frame& F, const int* cntg) {
    __syncthreads();
    for (int i = F.tid; i < 256 * NE; i += NWAVES * 64) F.MISC[MW_CNT + i] = (unsigned)cntg[i];
    __syncthreads();
    if (F.tid < NE) { unsigned s = 0; for (int c = 0; c < 256; ++c) s += F.MISC[MW_CNT + c * NE + F.tid]; F.MISC[MW_TOTAL + F.tid] = s; }
    __syncthreads();
    if (F.tid == 0) { unsigned st = 0;
        for (int e = 0; e < NE; ++e) { F.MISC[MW_START + e] = st; const unsigned nt_ = (F.MISC[MW_TOTAL + e] + 255u) >> 8; for (unsigned i = 0; i < nt_; ++i) F.MISC[MW_TEXP + (st >> 8) + i] = (unsigned)e; st += nt_ << 8; }
        F.MISC[MW_START + NE] = st; F.MISC[MW_NTILES] = st >> 8; }
    __syncthreads();
}

#include <hip/hip_bf16.h>
#include <cmath>
namespace mattn {
using bf16=__hip_bfloat16;
using bf16x8=__attribute__((ext_vector_type(8)))short;
using s16x4=__attribute__((ext_vector_type(4)))short;
using f32x16=__attribute__((ext_vector_type(16)))float;
using u32x4=__attribute__((ext_vector_type(4)))unsigned;
constexpr int BATCH=8,NHEAD=16,SEQ=4096,D=64,DM=NHEAD*D;
constexpr int NW=8,QBLK=32,QB=QBLK*NW,KVBLK=64,NQB=SEQ/QB;
constexpr int ATTN_PITCH=DM, ATTN_UNIT_ROWS=QB;
__device__ __forceinline__ int crow(int r,int hi){return (r&3)+8*(r>>2)+4*hi;}
#define SBAR() __builtin_amdgcn_sched_barrier(0)
__device__ __forceinline__ void cmask(f32x16&p0,f32x16&p1,int jb,int qrel,int hi){
  const float NEG=-INFINITY; int kb=64*jb+4*hi;
  #pragma unroll
  for(int r=0;r<16;++r){int kv=kb+(r&3)+8*(r>>2); if(kv>qrel)p0[r]=NEG; if(kv+32>qrel)p1[r]=NEG;}
}

constexpr int NSLOT=3, SLOTB=8192;
constexpr int LDS_K=0, LDS_V=NSLOT*SLOTB, LDS_WS=2*NSLOT*SLOTB, LDS_OST=LDS_WS+NW*64*4, LDS_KM=LDS_OST+NW*4096, LDS_BYTES=LDS_KM+4096;
constexpr float C2=0.125f*1.4426950408889634f;
__device__ __forceinline__ void glds16(const void*gsrc,unsigned lds_dst){unsigned keep;
  asm volatile("s_mov_b32 %0, m0\n\ts_mov_b32 m0, %2\n\ts_nop 0\n\tglobal_load_lds_dwordx4 %1, off\n\ts_mov_b32 m0, %0":"=&s"(keep):"v"(gsrc),"s"(lds_dst):"memory");}
__device__ __forceinline__ float max3f(float a,float b,float c){float r;asm("v_max3_f32 %0, %1, %2, %3":"=v"(r):"v"(a),"v"(b),"v"(c));return r;}
__device__ __forceinline__ float max2f(float a,float b){float r;asm("v_max_f32_e32 %0, %1, %2":"=v"(r):"v"(a),"v"(b));return r;}
__device__ __forceinline__ float fadd_s(float a,float b){float r;asm("v_add_f32_e32 %0, %1, %2":"=v"(r):"v"(a),"v"(b));return r;}
__device__ __forceinline__ float fsub_s(float a,float b){float r;asm("v_sub_f32_e32 %0, %1, %2":"=v"(r):"v"(a),"v"(b));return r;}
typedef float f32x2_t __attribute__((ext_vector_type(2))); typedef __bf16 bf16x2_t __attribute__((ext_vector_type(2)));
__device__ __forceinline__ unsigned cvtpk_s(float lo,float hi){f32x2_t v={lo,hi};bf16x2_t b=__builtin_convertvector(v,bf16x2_t);return __builtin_bit_cast(unsigned,b);}
#define WAIT_BAR(N) asm volatile("s_waitcnt vmcnt(" #N ") lgkmcnt(0)\n\ts_barrier":::"memory")

__device__ __forceinline__ void qkt(f32x16&p0,f32x16&p1,const char*Kslot,const bf16x8*qr,const bf16x8&kx0,const bf16x8&kx1,const bf16x8&qx,int r32,int hi){
  const char*kb=Kslot+hi*1024+r32*16;
  #pragma unroll
  for(int d0=0;d0<4;++d0){
    const bf16x8 b0=*reinterpret_cast<const bf16x8*>(kb+d0*2048);
    const bf16x8 b1=*reinterpret_cast<const bf16x8*>(kb+d0*2048+512);
    if(d0==0){p0=__builtin_amdgcn_mfma_f32_32x32x16_bf16(b0,qr[0],f32x16{},0,0,0);p1=__builtin_amdgcn_mfma_f32_32x32x16_bf16(b1,qr[0],f32x16{},0,0,0);}
    else{p0=__builtin_amdgcn_mfma_f32_32x32x16_bf16(b0,qr[d0],p0,0,0,0);p1=__builtin_amdgcn_mfma_f32_32x32x16_bf16(b1,qr[d0],p1,0,0,0);}}
  p0=__builtin_amdgcn_mfma_f32_32x32x16_bf16(kx0,qx,p0,0,0,0);p1=__builtin_amdgcn_mfma_f32_32x32x16_bf16(kx1,qx,p1,0,0,0);
}
__device__ __forceinline__ unsigned bfb(float f){unsigned u=__float_as_uint(f);return (u+0x7fffu+((u>>16)&1u))>>16;}
__device__ __forceinline__ void split3(float x,unsigned&h,unsigned&m,unsigned&l){h=bfb(x);const float r1=x-__uint_as_float(h<<16);m=bfb(r1);const float r2=r1-__uint_as_float(m<<16);l=bfb(r2);}
typedef __attribute__((address_space(3))) const char* lds_cptr;
typedef short v4i16_t __attribute__((ext_vector_type(4)));
__device__ __forceinline__ void kload8(bf16x8*kf,lds_cptr kp){
  kf[0]=*(const __attribute__((address_space(3))) bf16x8*)(kp);      kf[1]=*(const __attribute__((address_space(3))) bf16x8*)(kp+512);
  kf[2]=*(const __attribute__((address_space(3))) bf16x8*)(kp+2048); kf[3]=*(const __attribute__((address_space(3))) bf16x8*)(kp+2560);
  kf[4]=*(const __attribute__((address_space(3))) bf16x8*)(kp+4096); kf[5]=*(const __attribute__((address_space(3))) bf16x8*)(kp+4608);
  kf[6]=*(const __attribute__((address_space(3))) bf16x8*)(kp+6144); kf[7]=*(const __attribute__((address_space(3))) bf16x8*)(kp+6656);
}
__device__ __forceinline__ void kload2(bf16x8*kf,lds_cptr kp,int j){ kf[2*j]=*(const __attribute__((address_space(3))) bf16x8*)(kp+j*2048); kf[2*j+1]=*(const __attribute__((address_space(3))) bf16x8*)(kp+j*2048+512); }
__device__ __forceinline__ s16x4 vtr(lds_cptr p){ return __builtin_bit_cast(s16x4,__builtin_amdgcn_ds_read_tr16_b64_v4i16((__attribute__((address_space(3))) v4i16_t*)p)); }
__device__ __forceinline__ float rowmax(const f32x16&p0,const f32x16&p1){
  float a=max3f(p0[0],p0[1],p1[0]),b=max3f(p0[2],p0[3],p1[1]);a=max3f(a,p1[2],p1[3]);
  #pragma unroll
  for(int r=4;r<16;r+=4){a=max3f(a,p0[r],p0[r+1]);b=max3f(b,p0[r+2],p0[r+3]);a=max3f(a,p1[r],p1[r+1]);b=max3f(b,p1[r+2],p1[r+3]);}
  const float m=max2f(a,b);
  auto rr=__builtin_amdgcn_permlane32_swap(__float_as_uint(m),__float_as_uint(m),false,false);
  return max2f(__uint_as_float(rr[0]),__uint_as_float(rr[1]));
}
__device__ __forceinline__ void pv(f32x16*o,int vb,bf16x8 pa0,bf16x8 pa1,bf16x8 pa2,bf16x8 pa3){
  #pragma unroll
  for(int d0=0;d0<2;++d0){s16x4 lo[4],hi[4];
    #pragma unroll
    for(int ks=0;ks<4;++ks){
      asm volatile("ds_read_b64_tr_b16 %0,%1 offset:%c2":"=&v"(lo[ks]):"v"(vb),"i"(d0*4096+ks*1024):"memory");
      asm volatile("ds_read_b64_tr_b16 %0,%1 offset:%c2":"=&v"(hi[ks]):"v"(vb),"i"(d0*4096+ks*1024+512):"memory");}
    asm volatile("s_waitcnt lgkmcnt(0)":::"memory");SBAR();
    #define PK(k) (bf16x8){lo[k][0],lo[k][1],lo[k][2],lo[k][3],hi[k][0],hi[k][1],hi[k][2],hi[k][3]}
    o[d0]=__builtin_amdgcn_mfma_f32_32x32x16_bf16(pa0,PK(0),o[d0],0,0,0);
    o[d0]=__builtin_amdgcn_mfma_f32_32x32x16_bf16(pa1,PK(1),o[d0],0,0,0);
    o[d0]=__builtin_amdgcn_mfma_f32_32x32x16_bf16(pa2,PK(2),o[d0],0,0,0);
    o[d0]=__builtin_amdgcn_mfma_f32_32x32x16_bf16(pa3,PK(3),o[d0],0,0,0);
    #undef PK
  }
}

template<int THRL> __device__ __forceinline__ void moba_unit(int b,int h,int qb,int kkeep,const bf16*Q,const bf16*__restrict__ K,const bf16*__restrict__ V,bf16*O,const float*kmean,char*shm){
  int tid_=threadIdx.x; asm volatile("":"+v"(tid_));
  const int tid=tid_,lane=tid&63,r32=lane&31,hi=lane>>5; const int wid=__builtin_amdgcn_readfirstlane(tid>>6);
  const long rowbase=(long)b*SEQ; const int q0=qb*QB;
  const bf16*Qw=Q+(rowbase+q0+wid*QBLK)*DM+h*D;
  const bf16*Kh=K+rowbase*DM+h*D,*Vh=V+rowbase*DM+h*D;
  const unsigned lds0=(unsigned)(uintptr_t)shm;
  float*wsf=(float*)(shm+LDS_WS)+wid*64;
  { float*kmd=(float*)(shm+LDS_KM); const float*kms=kmean+(size_t)((b*NHEAD+h)*16)*64; kmd[tid]=kms[tid]; kmd[tid+512]=kms[tid+512]; }
  const bf16*ksrc=Kh+(long)lane*DM+wid*8;
  const bf16*vsrc=Vh+(long)(16*(wid&3)+(lane>>2))*DM+(wid>>2)*32+(lane&3)*8;
  const unsigned kdst=lds0+LDS_K+wid*1024, vdst=lds0+LDS_V+wid*1024;
  #define DMA_K(t,slot) glds16(ksrc+(long)(t)*KVBLK*DM,(unsigned)__builtin_amdgcn_readfirstlane(kdst+(slot)))
  #define DMA_V(t,slot) glds16(vsrc+(long)(t)*KVBLK*DM,(unsigned)__builtin_amdgcn_readfirstlane(vdst+(slot)))
  const int vb0=(int)(lds0+LDS_V)+((lane>>4)&1)*32+(lane&3)*8+(4*hi+((lane&15)>>2))*64;
  const char*Kbase=shm+LDS_K; bf16x8 kf[8];
  const lds_cptr shm3=(lds_cptr)shm; const lds_cptr kp0=shm3+LDS_K+hi*1024+r32*16; const lds_cptr vp0=shm3+LDS_V+((lane>>4)&1)*32+(lane&3)*8+(4*hi+((lane&15)>>2))*64;
  const int NT=(q0+QB)/KVBLK;
  const int t0=4*((qb>kkeep)?(qb-kkeep):0);
  DMA_K(t0,0);DMA_V(t0,0);DMA_K(t0+1,SLOTB);
  bf16x8 qr[4];
  #pragma unroll
  for(int d0=0;d0<4;++d0)qr[d0]=*reinterpret_cast<const bf16x8*>(&Qw[(long)r32*DM+d0*16+hi*8]);
  float mhat=0.f,l_reg=0.f;f32x16 o[2];o[0]=f32x16{};o[1]=f32x16{};
  unsigned selmask=0u; bool selcur=true;
  bf16x8 kx0,kx1,qx;
  { const float slope2=exp2f(-0.5f*(float)(h+1))*1.4426950408889634f;
    unsigned a0,a1,a2,b0_,b1_,b2_,c0,c1,c2; split3(slope2*(float)r32,a0,a1,a2); split3(slope2*(float)(r32+32),b0_,b1_,b2_); split3(slope2*64.f,c0,c1,c2);
    const unsigned one=0x3f80u;
    u32x4 w0,w1,wq;
    if(hi==0){ w0=(u32x4){a0|(a1<<16),a2|(c0<<16),c1|(c2<<16),one|(one<<16)}; w1=(u32x4){b0_|(b1_<<16),b2_|(c0<<16),c1|(c2<<16),one|(one<<16)}; wq=(u32x4){one|(one<<16),one,0u,0u}; }
    else     { w0=(u32x4){one,0u,0u,0u}; w1=w0; wq=(u32x4){0u,0u,0u,0u}; }
    kx0=__builtin_bit_cast(bf16x8,w0); kx1=__builtin_bit_cast(bf16x8,w1); qx=__builtin_bit_cast(bf16x8,wq); }
  #define SETQX() do{ unsigned h_,m_,l_; split3(selcur?-mhat:-1e30f,h_,m_,l_); u32x4 w_=__builtin_bit_cast(u32x4,qx); if(hi==0){w_[3]=h_|(m_<<16);}else{w_[0]=l_;} qx=__builtin_bit_cast(bf16x8,w_); }while(0)
  #define SETT(t) do{ const unsigned tb_=__float_as_uint((float)(t))>>16; u32x4 w_=__builtin_bit_cast(u32x4,qx); if(hi==0){w_[1]=0x3f80u|(tb_<<16);w_[2]=tb_|(tb_<<16);} qx=__builtin_bit_cast(bf16x8,w_); }while(0)
  #define BLK(t) do{ if((((t))&3)==0){ const int blk_=(t)>>2; selcur=(blk_==qb)||(((selmask>>blk_)&1u)!=0u); SETQX(); } }while(0)
  const int qrel=wid*QBLK+r32;
  #define CMASK(P0,P1,t) do{int jb_=(t)-(NT-4); if(jb_>=0)cmask(P0,P1,jb_,qrel,hi);}while(0)
  bool resc=false;
  #define START(P0,P1) do{ const float rm=rowmax(P0,P1); resc=false; \
    { const float dl=max2f(rm,-1024.f); mhat=fadd_s(mhat,dl); \
      _Pragma("unroll") for(int r=0;r<16;++r){P0[r]=fsub_s(P0[r],dl);P1[r]=fsub_s(P1[r],dl);} \
      SETQX(); } \
    _Pragma("unroll") for(int r=0;r<16;++r)P0[r]=__builtin_amdgcn_exp2f(P0[r]); }while(0)
  #define RESC() do{ if(resc){ asm volatile("s_waitcnt lgkmcnt(0)":::"memory"); \
      _Pragma("unroll") for(int d_=0;d_<2;++d_) _Pragma("unroll") for(int r=0;r<16;++r)o[d_][r]*=wsf[crow(r,hi)]; } }while(0)
  f32x16 pA0,pA1,pB0,pB1;
  int sl_prev=0,sl_cur=0,sl_next=SLOTB;
  #define ROT() do{sl_prev=sl_cur;sl_cur=sl_next;sl_next=(sl_next==(NSLOT-1)*SLOTB)?0:sl_next+SLOTB;}while(0)
  DMA_K(t0+2,2*SLOTB);
  WAIT_BAR(3);
  if(qb>0){
    const float*kmd=(const float*)(shm+LDS_KM)+hi*8; float gate[16];
    #pragma unroll
    for(int n=0;n<16;++n){ float s=0.f;
      if(n<qb){
        #pragma unroll
        for(int d0=0;d0<4;++d0){ const float4 a=*(const float4*)(kmd+n*64+d0*16), c=*(const float4*)(kmd+n*64+d0*16+4);
          #define QF(i) __uint_as_float(((unsigned)(unsigned short)qr[d0][i])<<16)
          s+=QF(0)*a.x+QF(1)*a.y+QF(2)*a.z+QF(3)*a.w+QF(4)*c.x+QF(5)*c.y+QF(6)*c.z+QF(7)*c.w;
          #undef QF
        }
        s+=__shfl_xor(s,32); }
      gate[n]=s; }
    #pragma unroll
    for(int k=0;k<3;++k){ float best=-INFINITY; int bi=-1;
      #pragma unroll
      for(int n=0;n<16;++n){ const bool ok=(n<qb)&&!((selmask>>n)&1u)&&(gate[n]>best); if(ok){best=gate[n];bi=n;} }
      if(bi>=0)selmask|=1u<<bi; }
    selcur=((selmask>>(t0>>2))&1u)!=0u;
  }
  SETQX(); SETT(t0);
  qkt(pA0,pA1,Kbase,qr,kx0,kx1,qx,r32,hi);asm volatile("s_nop 15\n\ts_nop 7":"+v"(pA0),"+v"(pA1));CMASK(pA0,pA1,t0);
  START(pA0,pA1);
  _Pragma("unroll") for(int r=0;r<16;++r)pA1[r]=__builtin_amdgcn_exp2f(pA1[r]);
  WAIT_BAR(0);
  DMA_K(t0+3,0);DMA_V(t0+1,SLOTB);
  ROT();
  kload8(kf,kp0+sl_cur);
  WAIT_BAR(2);
  s16x4 vlo[8],vhi[8]; u32x4 pw0,pw1,pw2,pw3;
  #define PKW(P,B) cvtpk_s(P[B],P[B+1])
  #define PAF(k) __builtin_bit_cast(bf16x8,pw##k)
  #define VFR(i) (bf16x8){vlo[i][0],vlo[i][1],vlo[i][2],vlo[i][3],vhi[i][0],vhi[i][1],vhi[i][2],vhi[i][3]}
  #define PIN(x) asm volatile("":"+v"(x))
  #define MX3(a,b,c) __builtin_fmaxf(__builtin_fmaxf((a),(b)),(c))
  #define GAPA(MF,A0,A1,A2,A3,W0,W1,PW) do{ MF; sacc+=A0; sacc+=A1; sacc+=A2; sacc+=A3; PIN(sacc); W0; W1; PIN(PW); SBAR(); }while(0)
  #define EX(v) __builtin_amdgcn_exp2f(v)
  #define GAPB(MF,X,B) do{ MF; X[B]=EX(X[B]); X[B+1]=EX(X[B+1]); X[B+2]=EX(X[B+2]); X[B+3]=EX(X[B+3]); PIN(X); SBAR(); }while(0)
  #define VRD(i) do{ vlo[i]=vtr(vp_+(((i)>>2)*4096+((i)&3)*1024)); vhi[i]=vtr(vp_+(((i)>>2)*4096+((i)&3)*1024+512)); }while(0)
  #define KRD(G,j) do{ if(G){ kload2(kf,kp0+sl_next,j); SBAR(); } }while(0)
  #define STEP(C0,C1,P0,P1,t,GK,GV,GL) do{ SBAR(); \
    const lds_cptr vp_=vp0+sl_prev; \
    VRD(0); SBAR(); float sacc=(P0[0]+P0[1]); \
    GAPA(C0=__builtin_amdgcn_mfma_f32_32x32x16_bf16(kf[0],qr[0],f32x16{},0,0,0), P0[2],P0[3],P0[4],P0[5],     pw0[0]=PKW(P0,0), pw0[1]=PKW(P0,2), pw0); \
    VRD(4); SBAR(); GAPA(C1=__builtin_amdgcn_mfma_f32_32x32x16_bf16(kf[1],qr[0],f32x16{},0,0,0), P0[6],P0[7],P0[8],P0[9],     pw0[2]=PKW(P0,4), pw0[3]=PKW(P0,6), pw0); \
    VRD(1); SBAR(); GAPA(C0=__builtin_amdgcn_mfma_f32_32x32x16_bf16(kf[2],qr[1],C0,0,0,0),   P0[10],P0[11],P0[12],P0[13], pw1[0]=PKW(P0,8), pw1[1]=PKW(P0,10), pw1); \
    VRD(5); SBAR(); GAPA(C1=__builtin_amdgcn_mfma_f32_32x32x16_bf16(kf[3],qr[1],C1,0,0,0),   P0[14],P0[15],P1[0],P1[1],   pw1[2]=PKW(P0,12),pw1[3]=PKW(P0,14), pw1); \
    VRD(2); SBAR(); GAPA(C0=__builtin_amdgcn_mfma_f32_32x32x16_bf16(kf[4],qr[2],C0,0,0,0),   P1[2],P1[3],P1[4],P1[5],     pw2[0]=PKW(P1,0), pw2[1]=PKW(P1,2), pw2); \
    VRD(6); SBAR(); GAPA(C1=__builtin_amdgcn_mfma_f32_32x32x16_bf16(kf[5],qr[2],C1,0,0,0),   P1[6],P1[7],P1[8],P1[9],     pw2[2]=PKW(P1,4), pw2[3]=PKW(P1,6), pw2); \
    VRD(3); SBAR(); GAPA(C0=__builtin_amdgcn_mfma_f32_32x32x16_bf16(kf[6],qr[3],C0,0,0,0),   P1[10],P1[11],P1[12],P1[13], pw3[0]=PKW(P1,8), pw3[1]=PKW(P1,10), pw3); \
    VRD(7); SBAR(); GAPA(C1=__builtin_amdgcn_mfma_f32_32x32x16_bf16(kf[7],qr[3],C1,0,0,0),   P1[14],P1[15],0.f,0.f,       pw3[2]=PKW(P1,12),pw3[3]=PKW(P1,14), pw3); \
    C0=__builtin_amdgcn_mfma_f32_32x32x16_bf16(kx0,qx,C0,0,0,0); C1=__builtin_amdgcn_mfma_f32_32x32x16_bf16(kx1,qx,C1,0,0,0); SBAR(); \
    l_reg+=sacc; \
    if(GK){DMA_K((t)+3,sl_cur);} if(GV){DMA_V((t)+1,sl_next);} \
    CMASK(C0,C1,t); \
    { float a=MX3(C0[0],C0[1],C1[0]),b=MX3(C0[2],C0[3],C1[1]); a=MX3(a,C1[2],C1[3]); \
      _Pragma("unroll") for(int r=4;r<16;r+=4){a=MX3(a,C0[r],C0[r+1]);b=MX3(b,C0[r+2],C0[r+3]);a=MX3(a,C1[r],C1[r+1]);b=MX3(b,C1[r+2],C1[r+3]);} \
      float rm=__builtin_fmaxf(a,b); { auto rr=__builtin_amdgcn_permlane32_swap(__float_as_uint(rm),__float_as_uint(rm),false,false); rm=__builtin_fmaxf(__uint_as_float(rr[0]),__uint_as_float(rr[1])); } \
      resc=false; \
      if(__builtin_expect(__any(rm>(float)THRL),0)){ const float dl=__builtin_fmaxf(rm,0.f); mhat+=dl; \
        _Pragma("unroll") for(int r=0;r<16;++r){C0[r]-=dl;C1[r]-=dl;} \
        SETQX(); \
        const float f=__builtin_amdgcn_exp2f(-dl); l_reg*=f; if(hi==0)wsf[r32]=f; resc=true; } } \
    SBAR(); \
    GAPB(o[0]=__builtin_amdgcn_mfma_f32_32x32x16_bf16(PAF(0),VFR(0),o[0],0,0,0), C0,0); \
    GAPB(o[1]=__builtin_amdgcn_mfma_f32_32x32x16_bf16(PAF(0),VFR(4),o[1],0,0,0), C0,4); \
    KRD(GL,0); GAPB(o[0]=__builtin_amdgcn_mfma_f32_32x32x16_bf16(PAF(1),VFR(1),o[0],0,0,0), C0,8); \
    KRD(GL,1); GAPB(o[1]=__builtin_amdgcn_mfma_f32_32x32x16_bf16(PAF(1),VFR(5),o[1],0,0,0), C0,12); \
    KRD(GL,2); GAPB(o[0]=__builtin_amdgcn_mfma_f32_32x32x16_bf16(PAF(2),VFR(2),o[0],0,0,0), C1,0); \
    KRD(GL,3); GAPB(o[1]=__builtin_amdgcn_mfma_f32_32x32x16_bf16(PAF(2),VFR(6),o[1],0,0,0), C1,4); \
    GAPB(o[0]=__builtin_amdgcn_mfma_f32_32x32x16_bf16(PAF(3),VFR(3),o[0],0,0,0), C1,8); \
    GAPB(o[1]=__builtin_amdgcn_mfma_f32_32x32x16_bf16(PAF(3),VFR(7),o[1],0,0,0), C1,12); \
    }while(0)
  int t=t0+1;
  #undef CMASK
  #define CMASK(P0,P1,t) do{}while(0)
  for(;t+5<NT;t+=2){
    SETT(t);   STEP(pB0,pB1,pA0,pA1,t,true,true,true);     WAIT_BAR(2); RESC(); ROT();
    BLK(t+1); SETT(t+1); STEP(pA0,pA1,pB0,pB1,t+1,true,true,true);   WAIT_BAR(2); RESC(); ROT();
  }
  #undef CMASK
  #define CMASK(P0,P1,t) do{int jb_=(t)-(NT-4); if(jb_>=0)cmask(P0,P1,jb_,qrel,hi);}while(0)
  #define ENDW(tt) do{ if((tt)+3<NT){WAIT_BAR(2);} else if((tt)+2<NT){WAIT_BAR(1);} else {WAIT_BAR(0);} }while(0)
  for(;t+1<NT;t+=2){
    SETT(t);   STEP(pB0,pB1,pA0,pA1,t,(t+3<NT),(t+1<NT),(t+1<NT));       ENDW(t);   RESC(); ROT();
    BLK(t+1); SETT(t+1); STEP(pA0,pA1,pB0,pB1,t+1,(t+4<NT),(t+2<NT),(t+2<NT));     ENDW(t+1); RESC(); ROT();
  }
  SETT(NT-1); STEP(pB0,pB1,pA0,pA1,NT-1,false,false,false); RESC();
  { float sacc=pB0[0]+pB0[1]; _Pragma("unroll") for(int r=2;r<16;++r)sacc+=pB0[r]; _Pragma("unroll") for(int r=0;r<16;++r)sacc+=pB1[r]; l_reg+=sacc;
    pw0=(u32x4){PKW(pB0,0),PKW(pB0,2),PKW(pB0,4),PKW(pB0,6)};pw1=(u32x4){PKW(pB0,8),PKW(pB0,10),PKW(pB0,12),PKW(pB0,14)};pw2=(u32x4){PKW(pB1,0),PKW(pB1,2),PKW(pB1,4),PKW(pB1,6)};pw3=(u32x4){PKW(pB1,8),PKW(pB1,10),PKW(pB1,12),PKW(pB1,14)};
    SBAR(); pv(o,vb0+sl_cur,PAF(0),PAF(1),PAF(2),PAF(3)); }
  #undef PKW
  #undef PAF
  #undef VFR
  #undef PIN
  #undef MX3
  #undef GAPA
  #undef GAPB
  #undef EX
  #undef VRD
  #undef KRD
  #undef STEP
  #undef ENDW
  #undef SETQX
  #undef SETT
  #undef BLK
  {auto rr=__builtin_amdgcn_permlane32_swap(__float_as_uint(l_reg),__float_as_uint(l_reg),false,false);l_reg=__uint_as_float(rr[0])+__uint_as_float(rr[1]);}
  if(hi==0)wsf[32+r32]=l_reg;asm volatile("s_waitcnt lgkmcnt(0)":::"memory");
  float rli[16];
  #pragma unroll
  for(int r=0;r<16;++r)rli[r]=__builtin_amdgcn_rcpf(wsf[32+crow(r,hi)]);
  bf16*Ow=O+(rowbase+q0+wid*QBLK)*DM+h*D;
  { bf16*stg=(bf16*)(shm+LDS_OST)+wid*2048;
    #pragma unroll
    for(int r=0;r<16;++r){const int orow=crow(r,hi);
      #pragma unroll
      for(int d0=0;d0<2;++d0)stg[orow*64+d0*32+r32]=__float2bfloat16(o[d0][r]*rli[r]);}
    asm volatile("s_waitcnt lgkmcnt(0)":::"memory");
    #pragma unroll
    for(int i=0;i<4;++i){const int row=i*8+(lane>>3),ch=lane&7; const u32x4 v=*(const u32x4*)(stg+row*64+ch*8); *(u32x4*)(Ow+(long)row*DM+ch*8)=v;} }
  asm volatile("s_waitcnt lgkmcnt(0)\n\ts_barrier":::"memory");
  #undef DMA_K
  #undef DMA_V
  #undef CMASK
  #undef START
  #undef RESC
  #undef ROT
}
constexpr int MOBA_LDS_BYTES=LDS_BYTES;

constexpr int SW_LDS_K=0, SW_LDS_V=4*SLOTB, SW_LDS_WS=8*SLOTB, SW_LDS_OST=SW_LDS_WS+NW*256, SW_LDS_BYTES=SW_LDS_OST+NW*4096;
__device__ __forceinline__ void swa_unit(int b,int nb,int kvh,bf16*QO,const bf16*__restrict__ KV,const float*sinks,char*shm){
  int tid_=threadIdx.x; asm volatile("":"+v"(tid_));
  const int tid=tid_,lane=tid&63,r32=lane&31,hi=lane>>5; const int wid=__builtin_amdgcn_readfirstlane(tid>>6);
  const int hq=kvh*8+wid; const long rowbase=(long)b*SEQ; const int q0=nb*128;
  const unsigned lds0=(unsigned)(uintptr_t)shm;
  float*wsf=(float*)(shm+SW_LDS_WS)+wid*64;
  const int c0=(nb==0)?2:0;
  for(int c=c0;c<4;++c){
    const long kp=rowbase+q0-128+64*c;
    glds16(KV+(kp+lane)*DM+kvh*64+wid*8,(unsigned)__builtin_amdgcn_readfirstlane(lds0+SW_LDS_K+c*SLOTB+wid*1024));
    glds16(KV+(kp+16*(wid&3)+(lane>>2))*DM+128+kvh*64+(wid>>2)*32+(lane&3)*8,(unsigned)__builtin_amdgcn_readfirstlane(lds0+SW_LDS_V+c*SLOTB+wid*1024)); }
  bf16x8 qr[4][4];
  #pragma unroll
  for(int i=0;i<4;++i)
    #pragma unroll
    for(int d0=0;d0<4;++d0)qr[i][d0]=*reinterpret_cast<const bf16x8*>(&QO[(rowbase+q0+32*i+r32)*DM+hq*64+d0*16+hi*8]);
  const float slope2=exp2f(-0.5f*(float)(hq+1))*1.4426950408889634f;
  const float sink2=sinks[hq]*1.4426950408889634f;
  bf16x8 kx0,kx1,qx;
  { unsigned a0,a1,a2,b0_,b1_,b2_,c0_,c1_,c2_; split3(slope2*(float)r32,a0,a1,a2); split3(slope2*(float)(r32+32),b0_,b1_,b2_); split3(slope2*64.f,c0_,c1_,c2_);
    const unsigned one=0x3f80u; u32x4 w0,w1,wq;
    if(hi==0){ w0=(u32x4){a0|(a1<<16),a2|(c0_<<16),c1_|(c2_<<16),one|(one<<16)}; w1=(u32x4){b0_|(b1_<<16),b2_|(c0_<<16),c1_|(c2_<<16),one|(one<<16)}; wq=(u32x4){one|(one<<16),one,0u,0u}; }
    else     { w0=(u32x4){one,0u,0u,0u}; w1=w0; wq=(u32x4){0u,0u,0u,0u}; }
    kx0=__builtin_bit_cast(bf16x8,w0); kx1=__builtin_bit_cast(bf16x8,w1); qx=__builtin_bit_cast(bf16x8,wq); }
  const int vb0=(int)(lds0+SW_LDS_V)+((lane>>4)&1)*32+(lane&3)*8+(4*hi+((lane&15)>>2))*64;
  asm volatile("s_waitcnt vmcnt(0) lgkmcnt(0)\n\ts_barrier":::"memory");
  #pragma unroll
  for(int i=0;i<4;++i){
    const int qi=32*i+r32;
    int cbeg=(i<2)?0:1; const int cend=cbeg+3; if(cbeg<c0)cbeg=c0;
    float mhat=0.f,l_reg=0.f; f32x16 o[2]; o[0]=f32x16{}; o[1]=f32x16{};
    { unsigned h_,m_,l_; split3(0.f,h_,m_,l_); u32x4 w_=__builtin_bit_cast(u32x4,qx); if(hi==0){w_[3]=h_|(m_<<16);}else{w_[0]=l_;} qx=__builtin_bit_cast(bf16x8,w_); }
    for(int c=cbeg;c<cend;++c){
      { const unsigned tb_=__float_as_uint((float)c)>>16; u32x4 w_=__builtin_bit_cast(u32x4,qx); if(hi==0){w_[1]=0x3f80u|(tb_<<16);w_[2]=tb_|(tb_<<16);} qx=__builtin_bit_cast(bf16x8,w_); }
      f32x16 p0,p1; qkt(p0,p1,shm+SW_LDS_K+c*SLOTB,qr[i],kx0,kx1,qx,r32,hi);
      { const int lo_=qi+1-64*c, hi_=qi+128-64*c;
        #pragma unroll
        for(int r=0;r<16;++r){ const int kv=crow(r,hi); if(kv<lo_||kv>hi_)p0[r]=-INFINITY; if(kv+32<lo_||kv+32>hi_)p1[r]=-INFINITY; } }
      const float rm=rowmax(p0,p1); const bool first=(c==cbeg);
      if(first||__any(rm>100.f)){
        const float dl=first?fmaxf(rm,-1024.f):fmaxf(rm,0.f); mhat+=dl;
        #pragma unroll
        for(int r=0;r<16;++r){p0[r]-=dl;p1[r]-=dl;}
        if(!first){ const float f=__builtin_amdgcn_exp2f(-dl); l_reg*=f; if(hi==0)wsf[r32]=f; asm volatile("s_waitcnt lgkmcnt(0)":::"memory");
          #pragma unroll
          for(int d_=0;d_<2;++d_)
            #pragma unroll
            for(int r=0;r<16;++r)o[d_][r]*=wsf[crow(r,hi)]; }
        { unsigned h_,m_,l_; split3(-mhat,h_,m_,l_); u32x4 w_=__builtin_bit_cast(u32x4,qx); if(hi==0){w_[3]=h_|(m_<<16);}else{w_[0]=l_;} qx=__builtin_bit_cast(bf16x8,w_); }
      }
      float sacc=0.f;
      #pragma unroll
      for(int r=0;r<16;++r){p0[r]=__builtin_amdgcn_exp2f(p0[r]);p1[r]=__builtin_amdgcn_exp2f(p1[r]);sacc+=p0[r]+p1[r];}
      l_reg+=sacc;
      const u32x4 pw0={cvtpk_s(p0[0],p0[1]),cvtpk_s(p0[2],p0[3]),cvtpk_s(p0[4],p0[5]),cvtpk_s(p0[6],p0[7])},pw1={cvtpk_s(p0[8],p0[9]),cvtpk_s(p0[10],p0[11]),cvtpk_s(p0[12],p0[13]),cvtpk_s(p0[14],p0[15])};
      const u32x4 pw2={cvtpk_s(p1[0],p1[1]),cvtpk_s(p1[2],p1[3]),cvtpk_s(p1[4],p1[5]),cvtpk_s(p1[6],p1[7])},pw3={cvtpk_s(p1[8],p1[9]),cvtpk_s(p1[10],p1[11]),cvtpk_s(p1[12],p1[13]),cvtpk_s(p1[14],p1[15])};
      pv(o,vb0+c*SLOTB,__builtin_bit_cast(bf16x8,pw0),__builtin_bit_cast(bf16x8,pw1),__builtin_bit_cast(bf16x8,pw2),__builtin_bit_cast(bf16x8,pw3));
    }
    {auto rr=__builtin_amdgcn_permlane32_swap(__float_as_uint(l_reg),__float_as_uint(l_reg),false,false);l_reg=__uint_as_float(rr[0])+__uint_as_float(rr[1]);}
    l_reg+=__builtin_amdgcn_exp2f(sink2+slope2*(float)(128+qi)-mhat);
    if(hi==0)wsf[32+r32]=l_reg;asm volatile("s_waitcnt lgkmcnt(0)":::"memory");
    float rli[16];
    #pragma unroll
    for(int r=0;r<16;++r)rli[r]=__builtin_amdgcn_rcpf(wsf[32+crow(r,hi)]);
    bf16*Ow=QO+(rowbase+q0+32*i)*DM+hq*64;
    { bf16*stg=(bf16*)(shm+SW_LDS_OST)+wid*2048;
      #pragma unroll
      for(int r=0;r<16;++r){const int orow=crow(r,hi);
        #pragma unroll
        for(int d0=0;d0<2;++d0)stg[orow*64+d0*32+r32]=__float2bfloat16(o[d0][r]*rli[r]);}
      asm volatile("s_waitcnt lgkmcnt(0)":::"memory");
      #pragma unroll
      for(int j=0;j<4;++j){const int row=j*8+(lane>>3),ch=lane&7; const u32x4 v=*(const u32x4*)(stg+row*64+ch*8); *(u32x4*)(Ow+(long)row*DM+ch*8)=v;}
      asm volatile("s_waitcnt lgkmcnt(0)":::"memory"); }
  }
  asm volatile("s_waitcnt lgkmcnt(0)\n\ts_barrier":::"memory");
}
#undef SBAR
#undef WAIT_BAR
}

__device__ const int MOBA_KH[16] = {1, 2, 2, 3, 4, 5, 7, 9, 13, 15, 15, 15, 15, 15, 15, 15};
constexpr int MOBA_ML = 8;
__device__ const unsigned char MOBA_TAB[32][MOBA_ML] = {
  {255,126,246,150,63,178,31,208},
  {239,125,230,134,62,162,30,192},
  {223,124,214,118,61,146,29,176},
  {207,123,198,102,60,130,28,160},
  {191,122,182,245,116,114,27,144},
  {175,121,166,229,100,98,26,128},
  {159,248,200,228,84,82,25,112},
  {254,217,184,212,79,66,24,96},
  {238,201,168,196,78,50,23,80},
  {222,185,152,180,77,47,22,64},
  {206,169,136,164,76,46,21,48},
  {190,153,120,148,75,45,20,32},
  {174,137,247,213,74,44,19,16},
  {158,127,231,197,73,43,18,0},
  {253,250,215,181,72,42,241,17},
  {237,234,199,165,71,41,225,15},
  {221,218,183,149,70,40,209,14},
  {205,202,167,133,69,39,193,13},
  {189,186,151,117,68,38,177,12},
  {173,170,135,101,243,59,161,11},
  {157,154,119,95,227,58,145,10},
  {143,138,111,94,211,57,129,9},
  {142,249,232,93,195,56,113,8},
  {141,233,216,92,179,55,97,7},
  {252,251,110,91,163,54,81,6},
  {236,235,109,90,147,53,65,5},
  {220,219,108,89,131,52,49,4},
  {204,203,107,88,115,51,33,3},
  {188,187,106,87,99,242,37,2},
  {172,171,105,86,83,226,36,1},
  {156,155,104,85,67,210,35,240},
  {140,139,103,244,132,194,34,224}};
constexpr int N_PHASES = 17;
#ifndef MK_ONE_LAUNCH
#define MK_ONE_LAUNCH 1
#endif
__global__ void __launch_bounds__(NWAVES * 64, 2) fwd_kernel(Args args) {
    extern __shared__ __attribute__((aligned(16))) unsigned char lds[];
    Frame F;
    F.lds = (LAS unsigned char*)lds;
    F.MISC = (volatile LAS unsigned*)(F.lds + MISC_OFF);
    F.tid = threadIdx.x; F.lane = F.tid & 63; F.wave = __builtin_amdgcn_readfirstlane(F.tid >> 6);
    F.G = gridDim.x; F.ws = args.ws; F.ctl = (gu32*)(args.ws + WS_CTL);
#define ws (args.ws)
    const int lo = args.ph_lo, hi = args.ph_hi;
    if (F.tid < 16) F.MISC[F.tid] = 0u;
    __syncthreads();
    XcdBarrier bar; bar.bar = (unsigned*)(F.ctl + CW_BAR); bar.x = 0; bar.st = nullptr;
    if (MK_ONE_LAUNCH) bar = xcd_barrier_post((unsigned*)(F.ctl + CW_BAR), F.MISC + MW_BAR);
#define IN(k) (lo <= (k) && (k) < hi)
#define GRID_BAR() do { if (MK_ONE_LAUNCH) xcd_barrier(bar); } while (0)
    const int gw = blockIdx.x * NWAVES + F.wave, NGW = F.G * NWAVES;

#define x_in (args.in[0])
#define w_qkv_a (args.in[1])
#define w_o_a (args.in[2])
#define w_kv_sh (args.in[3])
#define w_q_b (args.in[4])
#define w_o_b (args.in[5])
#define sinks_b (args.in[6])
#define w_gate_d (args.in[7])
#define w_up_d (args.in[8])
#define w_down_d (args.in[9])
#define w_router (args.in[10])
#define w_gate_e (args.in[11])
#define w_up_e (args.in[12])
#define w_down_e (args.in[13])
#define ln_gain (args.in[14])
#define ln_bias (args.in[15])
    float* const out = args.out;
#define Wqkv_t ((bf16*)(ws + WS_WQKV))
#define Woa_t ((bf16*)(ws + WS_WOA))
#define Wgud_t ((bf16*)(ws + WS_WGUD))
#define Wdd_t ((bf16*)(ws + WS_WDD))
#define Wqb_t ((bf16*)(ws + WS_WQB))
#define Wob_t ((bf16*)(ws + WS_WOB))
#define Wgue8 ((unsigned char*)(ws + WS_WGUE))
#define Wde8 ((unsigned char*)(ws + WS_WDE))
#define X8 ((unsigned char*)(ws + WS_X8))
#define H8 ((unsigned char*)(ws + WS_H))
#define XB ((bf16*)(ws + WS_XB))
#define QB ((bf16*)(ws + WS_Q))
#define KB ((bf16*)(ws + WS_K))
#define VB ((bf16*)(ws + WS_V))
#define HB ((bf16*)(ws + WS_H))
#define kmean ((float*)(ws + WS_KMEAN))
#define rowtok ((int*)(ws + R_ROWTOK))
#define rowpair ((int*)(ws + R_ROWPAIR))
#define roww ((float*)(ws + R_ROWW))
#define re ((int*)(ws + R_RE))
#define rwf ((float*)(ws + R_RWF))
#define cntg ((int*)(ws + R_CNT))
#define pairpos ((int*)(ws + R_PPOS))
#define PARTB ((float*)(ws + WS_PART))
#define YP ((bf16*)out)
#define X1H ((bf16*)out)
#define X2H ((bf16*)out + (size_t)T * D)
#define X3H XB

    if (IN(0)) {
        LAS float* scr = (LAS float*)(F.lds + F.wave * 16384);
        constexpr int I_QKV = 16 * 96, I_SQ = 16 * 32, I_GD = 16 * 88, I_DD = 44 * 32, I_KV = 16 * 8, I_GE = 16 * 112, I_DE = 56 * 32;
        constexpr int NITEMS = I_QKV + I_SQ + 2 * I_GD + I_DD + I_SQ + I_KV + I_SQ;
        for (int it = gw; it < NITEMS; it += NGW) {
            int r = it;
            if (r < I_QKV) { tr_job(w_qkv_a, D, 3 * D, Wqkv_t, D, 0, 0, scr, r, F.lane); continue; } r -= I_QKV;
            if (r < I_SQ) { tr_job(w_o_a, D, D, Woa_t, D, 0, 0, scr, r, F.lane); continue; } r -= I_SQ;
            if (r < I_GD) { tr_job8<true>(w_gate_d, D, FFD, (unsigned char*)Wgud_t, D, 1, WSC_GU, scr, r, F.lane); continue; } r -= I_GD;
            if (r < I_GD) { tr_job8<true>(w_up_d, D, FFD, (unsigned char*)Wgud_t, D, 2, WSC_GU, scr, r, F.lane); continue; } r -= I_GD;
            if (r < I_DD) { tr_job8<false>(w_down_d, FFD, D, (unsigned char*)Wdd_t, FFD, 0, WSC_D, scr, r, F.lane); continue; } r -= I_DD;
            if (r < I_SQ) { tr_job<true>(w_q_b, D, D, Wqb_t, D, 0, 0, scr, r, F.lane); continue; } r -= I_SQ;
            if (r < I_KV) { tr_job<true>(w_kv_sh, D, 256, Wqb_t, D, 0, D, scr, r, F.lane); continue; } r -= I_KV;
            tr_job(w_o_b, D, D, Wob_t, D, 0, 0, scr, r, F.lane);
        }
        for (int i = gw * 64 + F.lane; i < BATCH * NH * NBLK * HD; i += NGW * 64) kmean[i] = 0.f;
        for (size_t i = (size_t)gw * 64 + F.lane; i < (size_t)T * D / 8; i += (size_t)NGW * 64) {
            const f32x4 a = *(const f32x4*)(x_in + i * 8), c = *(const f32x4*)(x_in + i * 8 + 4);
            v4u o; o.x = pk2(a.x, a.y); o.y = pk2(a.z, a.w); o.z = pk2(c.x, c.y); o.w = pk2(c.z, c.w); *(v4u*)(XB + i * 8) = o; }
        GRID_BAR();
    }
    if (IN(1)) {
        pg8::Gemm g{XB, Wqkv_t, D, D, D}; pg8::StaticOrder S; S.init(T / 256, 3 * D / 256, F.G, (int)blockIdx.x);
        pg8::EpiBf16 E{QB, D, D, (size_t)(WS_K - WS_Q) / 2, C2, kmean};
        pg8::gemm_phase<pg8::EpiBf16, pg8::StaticOrder, true, false>(F.lds, g, S, E);
        GRID_BAR();
    }
    constexpr int MW_GE = 16 * 112, MW_DE = 56 * 32, NMOEW = 16 * MW_GE + 8 * MW_DE;
#define MOE_WITEM(ridx) do { int r = (ridx); LAS float* scr = (LAS float*)(F.lds + F.wave * 16384); \
        if (r < 16 * MW_GE) { const int j = r / MW_GE, e = j >> 1, up = j & 1; r -= j * MW_GE; \
            tr_job8<true>((up ? w_up_e : w_gate_e) + (size_t)e * D * FFE, D, FFE, Wgue8 + (size_t)e * 2 * FFE * D, D, 1 + up, WSC_GU, scr, r, F.lane); } \
        else { r -= 16 * MW_GE; const int e = r / MW_DE; r -= e * MW_DE; \
            tr_job8<false>(w_down_e + (size_t)e * FFE * D, FFE, D, Wde8 + (size_t)e * D * FFE, FFE, 0, WSC_D, scr, r, F.lane); } } while (0)
    if (IN(3)) {
        if (F.G == 256) { const int x = blockIdx.x & 7, l = blockIdx.x >> 3;
            for (int j = 0; j < MOBA_ML; ++j) { const int code = MOBA_TAB[l][j], h = code >> 4, qbt = code & 15;
                mattn::moba_unit<100>(x, h, qbt, MOBA_KH[h], (const mattn::bf16*)QB, (const mattn::bf16*)KB, (const mattn::bf16*)VB, (mattn::bf16*)XB, kmean, (char*)lds);
                for (int rr = j; rr * NGW + gw < NMOEW; rr += MOBA_ML) MOE_WITEM(rr * NGW + gw);
                VM_WAIT(); __syncthreads(); } }
        else { for (int u = blockIdx.x; u < BATCH * NH * NBLK; u += F.G) { const int bh = u >> 4, h = bh % NH;
                mattn::moba_unit<100>(bh / NH, h, u & 15, MOBA_KH[h], (const mattn::bf16*)QB, (const mattn::bf16*)KB, (const mattn::bf16*)VB, (mattn::bf16*)XB, kmean, (char*)lds); }
            for (int i = gw; i < NMOEW; i += NGW) MOE_WITEM(i); }
        GRID_BAR();
    }
    if (IN(4)) {
        pg8::Gemm g{XB, Woa_t, D, D, D}; pg8::StaticOrder S; S.init(T / 256, D / 256, F.G, (int)blockIdx.x);
        pg8::EpiBf16 E{QB, D, 0, 0, 1.f, nullptr};
        pg8::gemm_phase<pg8::EpiBf16, pg8::StaticOrder, true, false>(F.lds, g, S, E);
        GRID_BAR();
    }
#define LN_LOAD(XH16, XIN, MIX, m_, xv_, mv_) do { _Pragma("unroll") for (int j = 0; j < 4; ++j) { \
        if (XH16) { const unsigned long long t_ = *(const unsigned long long*)((const bf16*)(XIN) + (size_t)(m_) * D + 256 * j + 4 * F.lane); xv_[j] = (f32x4){hlo((unsigned)t_), hhi((unsigned)t_), hlo((unsigned)(t_ >> 32)), hhi((unsigned)(t_ >> 32))}; } \
        else xv_[j] = *(const f32x4*)((const float*)(XIN) + (size_t)(m_) * D + 256 * j + 4 * F.lane); \
        mv_[j] = *(const unsigned long long*)((MIX) + (size_t)(m_) * D + 256 * j + 4 * F.lane); } } while (0)
#define LN_MIX(v, xv, mv) do { _Pragma("unroll") for (int j = 0; j < 4; ++j) v[j] = (f32x4){ALPHA * xv[j].x + bflo((unsigned)mv[j]), ALPHA * xv[j].y + bfhi((unsigned)mv[j]), ALPHA * xv[j].z + bflo((unsigned)(mv[j] >> 32)), ALPHA * xv[j].w + bfhi((unsigned)(mv[j] >> 32))}; } while (0)
#define LN_STORE_H(XOUT, m_, v) do { _Pragma("unroll") for (int j = 0; j < 4; ++j) *(unsigned long long*)((XOUT) + (size_t)(m_) * D + 256 * j + 4 * F.lane) = (unsigned long long)pkh2(v[j].x, v[j].y) | ((unsigned long long)pkh2(v[j].z, v[j].w) << 32); } while (0)
#define LN_STORE_Q8(m_, v) do { _Pragma("unroll") for (int j = 0; j < 4; ++j) *(unsigned*)(X8 + (size_t)(m_) * D + 256 * j + 4 * F.lane) = pg8::pk4_i8(v[j].x * XSC, v[j].y * XSC, v[j].z * XSC, v[j].w * XSC); } while (0)
#define LN_PHASE(li, XH16, XIN, MIX, XOUT, Q8OUT) do { LnPar P; ln_load_par(P, ln_gain + (li) * D, ln_bias + (li) * D, F.lane); \
        f32x4 xv[4], xn[4]; unsigned long long mv[4], mn[4]; \
        if (gw < T) LN_LOAD(XH16, XIN, MIX, gw, xv, mv); \
        for (int m = gw; m < T; m += NGW) { f32x4 v[4]; \
            if (m + NGW < T) LN_LOAD(XH16, XIN, MIX, m + NGW, xn, mn);             \
            LN_MIX(v, xv, mv); ln_row(v, P); LN_STORE_H(XOUT, m, v); if (Q8OUT) LN_STORE_Q8(m, v); \
            _Pragma("unroll") for (int j = 0; j < 4; ++j) { xv[j] = xn[j]; mv[j] = mn[j]; } } } while (0)
    if (IN(5)) { LN_PHASE(0, false, x_in, QB, X1H, true); GRID_BAR(); }
    if (IN(6)) {
        pg8::Gemm g{(const pg8::bf16_t*)X8, Wgud_t, D, D, D}; pg8::StaticOrder S; S.init(T / 256, 2 * FFD / 256, F.G, (int)blockIdx.x);
        pg8::EpiSwigluF8<true> E{H8, FFD, 1.f / (XSC * WSC_GU), HSC};
        pg8::gemm_phase<pg8::EpiSwigluF8<true>, pg8::StaticOrder, true, false, 2>(F.lds, g, S, E);
        GRID_BAR();
    }
    if (IN(7)) {
        pg8::Gemm g{(const pg8::bf16_t*)H8, Wdd_t, FFD, FFD, FFD}; pg8::StaticOrder S; S.init(T / 256, D / 256, F.G, (int)blockIdx.x);
        pg8::EpiBf16 E{XB, D, 0, 0, 1.f / (HSC * WSC_D), nullptr};
        pg8::gemm_phase<pg8::EpiBf16, pg8::StaticOrder, true, false, 1>(F.lds, g, S, E);
        GRID_BAR();
    }
    if (IN(8)) { LN_PHASE(1, true, X1H, XB, X2H, false); GRID_BAR(); }
    if (IN(9)) {
        pg8::Gemm g{X2H, Wqb_t, D, D, D}; pg8::StaticOrder S; S.init(T / 256, 1280 / 256, F.G, (int)blockIdx.x);
        pg8::EpiBf16 E{QB, D, D, (size_t)(WS_K - WS_Q) / 2, C2, nullptr};
        pg8::gemm_phase<pg8::EpiBf16, pg8::StaticOrder, true, false, 3>(F.lds, g, S, E);
        GRID_BAR();
    }
    if (IN(10)) {
        for (int u = blockIdx.x; u < BATCH * (SEQ / SW) * 2; u += F.G) { const int b = u >> 6, nb = (u & 63) >> 1, kvh = u & 1; mattn::swa_unit(b, nb, kvh, (mattn::bf16*)QB, (const mattn::bf16*)KB, sinks_b, (char*)lds); }
        GRID_BAR();
    }
    if (IN(11)) {
        pg8::Gemm g{QB, Wob_t, D, D, D}; pg8::StaticOrder S; S.init(T / 256, D / 256, F.G, (int)blockIdx.x);
        pg8::EpiBf16 E{KB, D, 0, 0, 1.f, nullptr};
        pg8::gemm_phase<pg8::EpiBf16, pg8::StaticOrder, true, false>(F.lds, g, S, E);
        GRID_BAR();
    }
    if (IN(12)) {
        LnPar P; ln_load_par(P, ln_gain + 2 * D, ln_bias + 2 * D, F.lane);
        LAS int* sre = (LAS int*)(F.lds);
        for (int c = blockIdx.x; c < T / 128; c += F.G) {
            __syncthreads();
            f32x4 xv[4], xn[4]; unsigned long long mv[4], mn[4];
            LN_LOAD(true, X2H, KB, c * 128 + F.wave * 16, xv, mv);
            for (int j16 = 0; j16 < 16; ++j16) {
                const int m = c * 128 + F.wave * 16 + j16; f32x4 v[4];
                if (j16 < 15) LN_LOAD(true, X2H, KB, m + 1, xn, mn);
                LN_MIX(v, xv, mv);
#pragma unroll
                for (int j = 0; j < 4; ++j) { xv[j] = xn[j]; mv[j] = mn[j]; }
                ln_row(v, P);
                LN_STORE_H(X3H, m, v); LN_STORE_Q8(m, v);
                float lg[NE];
#pragma unroll
                for (int e = 0; e < NE; ++e) lg[e] = 0.f;
#pragma unroll
                for (int j = 0; j < 4; ++j)
#pragma unroll
                    for (int i = 0; i < 4; ++i) { const float* wr_ = w_router + (size_t)(256 * j + 4 * F.lane + i) * NE; const f32x4 wa = *(const f32x4*)wr_, wb = *(const f32x4*)(wr_ + 4); const float xv = v[j][i];
                        lg[0] += xv * wa.x; lg[1] += xv * wa.y; lg[2] += xv * wa.z; lg[3] += xv * wa.w; lg[4] += xv * wb.x; lg[5] += xv * wb.y; lg[6] += xv * wb.z; lg[7] += xv * wb.w; }
#pragma unroll
                for (int e = 0; e < NE; ++e) lg[e] = wave_sum(lg[e]);
                int e0 = 0; float v0 = lg[0];
#pragma unroll
                for (int e = 1; e < NE; ++e) if (lg[e] > v0) { v0 = lg[e]; e0 = e; }
                int e1 = -1; float v1 = -INFINITY;
#pragma unroll
                for (int e = 0; e < NE; ++e) if (e != e0 && lg[e] > v1) { v1 = lg[e]; e1 = e; }
                const float p1 = __expf(v1 - v0), w0 = 1.f / (1.f + p1), w1 = p1 * w0;
                if (F.lane == 0) { re[m] = e0 | (e1 << 8); rwf[2 * m] = w0; rwf[2 * m + 1] = w1; sre[F.wave * 16 + j16] = e0 | (e1 << 8); }
            }
            __syncthreads();
            if (F.tid < NE) { int cnt = 0; for (int i = 0; i < 128; ++i) { const int pe = sre[i]; cnt += ((pe & 255) == F.tid) + ((pe >> 8) == F.tid); } cntg[c * NE + F.tid] = cnt; }
        }
        GRID_BAR();
    }
    if (IN(13)) {
        route_tables(F, cntg);
        for (int c = blockIdx.x; c < T / 128; c += F.G) {
            __syncthreads();
            if (F.tid < NE) { unsigned s = F.MISC[MW_START + F.tid]; for (int cc = 0; cc < c; ++cc) s += F.MISC[MW_CNT + cc * NE + F.tid]; F.MISC[MW_CBASE + F.tid] = s; }
            if (F.tid < 256) { const int tok = c * 128 + (F.tid >> 1), k = F.tid & 1; F.MISC[MW_SPAIR + F.tid] = (unsigned)((re[tok] >> (8 * k)) & 255); }
            __syncthreads();
            if (F.tid < 256) { const int tok = c * 128 + (F.tid >> 1), k = F.tid & 1; const unsigned e = F.MISC[MW_SPAIR + F.tid]; unsigned rank = 0;
                for (int p = 0; p < F.tid; ++p) rank += (F.MISC[MW_SPAIR + p] == e) ? 1u : 0u;
                const unsigned pos = F.MISC[MW_CBASE + e] + rank;
                rowtok[pos] = tok; rowpair[pos] = 2 * tok + k; roww[pos] = rwf[2 * tok + k]; pairpos[2 * tok + k] = (int)pos; }
        }
        if (blockIdx.x == 0) {
            for (int e = 0; e < NE; ++e) { const unsigned a = F.MISC[MW_START + e] + F.MISC[MW_TOTAL + e], z = F.MISC[MW_START + e + 1];
                for (unsigned p = a + F.tid; p < z; p += NWAVES * 64) { rowtok[p] = 0; rowpair[p] = -1; roww[p] = 0.f; } }
        }
        GRID_BAR();
    }
    if (IN(14)) {
        if (!MK_ONE_LAUNCH) route_tables(F, cntg);
        const int ntl = (int)F.MISC[MW_NTILES];
        pg8::Gemm g{(const pg8::bf16_t*)X8, (const pg8::bf16_t*)Wgue8, D, D, D};
        pg8::MoeOrder S; S.so.init(ntl, FFE / 128, F.G, (int)blockIdx.x); S.texp = (const LAS int*)(F.MISC + MW_TEXP); S.estride = (size_t)2 * FFE * D; S.rows = rowtok;
        pg8::EpiSwigluF8<true> E{H8, FFE, 1.f / (XSC * WSC_GU), HSC};
        pg8::gemm_phase<pg8::EpiSwigluF8<true>, pg8::MoeOrder, true, true, 2>(F.lds, g, S, E);
        GRID_BAR();
    }
    if (IN(15)) {
        if (!MK_ONE_LAUNCH) route_tables(F, cntg);
        const int ntl = (int)F.MISC[MW_NTILES];
        pg8::Gemm g{(const pg8::bf16_t*)H8, (const pg8::bf16_t*)Wde8, FFE, FFE, FFE};
        pg8::MoeOrder S; S.so.init(ntl < MAINTILES ? ntl : MAINTILES, D / 256, F.G, (int)blockIdx.x); S.texp = (const LAS int*)(F.MISC + MW_TEXP); S.estride = (size_t)D * FFE; S.rows = rowtok;
        pg8::EpiMoeDown E{YP, rowpair, roww, 1.f / (HSC * WSC_D)};
        pg8::gemm_phase<pg8::EpiMoeDown, pg8::MoeOrder, true, false, 1>(F.lds, g, S, E);
        if (ntl > MAINTILES) {
            pg8::Gemm g2{(const pg8::bf16_t*)H8, (const pg8::bf16_t*)Wde8, KSLICE, FFE, FFE};
            pg8::SplitOrder S2; S2.total = (ntl - MAINTILES) * 4 * NKS; S2.G = F.G; S2.c = (int)blockIdx.x; S2.tile0 = MAINTILES; S2.nks = NKS; S2.texp = (const LAS int*)(F.MISC + MW_TEXP); S2.estride = (size_t)D * FFE; S2.kslice = KSLICE; S2.rows = rowtok;
            pg8::EpiPartial E2{PARTB, roww, 1.f / (HSC * WSC_D), MAINTILES, LEFTTILES * 256};
            pg8::gemm_phase<pg8::EpiPartial, pg8::SplitOrder, true, false, 1>(F.lds, g2, S2, E2);
        }
        GRID_BAR();
    }
    if (IN(16)) {
        const unsigned bad = MK_ONE_LAUNCH ? __hip_atomic_load((unsigned*)(F.ctl + CW_BAR) + XB_TMO, RLX_AGENT) : 0u;
        f32x4 gq[4], bq[4];
#pragma unroll
        for (int j = 0; j < 2; ++j) { gq[2 * j] = *(const f32x4*)(ln_gain + 3 * D + 512 * j + 8 * F.lane); gq[2 * j + 1] = *(const f32x4*)(ln_gain + 3 * D + 512 * j + 8 * F.lane + 4);
            bq[2 * j] = *(const f32x4*)(ln_bias + 3 * D + 512 * j + 8 * F.lane); bq[2 * j + 1] = *(const f32x4*)(ln_bias + 3 * D + 512 * j + 8 * F.lane + 4); }
#define FIN_LOAD(m_, xw_, y0_, y1_) do { _Pragma("unroll") for (int j = 0; j < 2; ++j) { xw_[j] = *(const v4u*)(XB + (size_t)(m_) * D + 512 * j + 8 * F.lane); y0_[j] = *(const v4u*)(YP + (size_t)(2 * (m_)) * D + 512 * j + 8 * F.lane); y1_[j] = *(const v4u*)(YP + (size_t)(2 * (m_) + 1) * D + 512 * j + 8 * F.lane); } } while (0)
        v4u xwc[2], y0c[2], y1c[2], xwn[2], y0n[2], y1n[2];
        if (gw < T) FIN_LOAD(gw, xwc, y0c, y1c);
        for (int m = gw; m < T; m += NGW) {
            f32x4 v[4];
            if (m + NGW < T) FIN_LOAD(m + NGW, xwn, y0n, y1n);
            const int pp0 = __builtin_amdgcn_readfirstlane(pairpos[2 * m]), pp1 = __builtin_amdgcn_readfirstlane(pairpos[2 * m + 1]);
#pragma unroll
            for (int j = 0; j < 2; ++j) { const v4u xw = xwc[j], y0 = y0c[j], y1 = y1c[j];
                f32x4 a0 = (f32x4){bflo(y0.x), bfhi(y0.x), bflo(y0.y), bfhi(y0.y)}, a1 = (f32x4){bflo(y0.z), bfhi(y0.z), bflo(y0.w), bfhi(y0.w)};
                f32x4 b0 = (f32x4){bflo(y1.x), bfhi(y1.x), bflo(y1.y), bfhi(y1.y)}, b1 = (f32x4){bflo(y1.z), bfhi(y1.z), bflo(y1.w), bfhi(y1.w)};
                if (pp0 >= MAINTILES * 256) { a0 = (f32x4){0.f, 0.f, 0.f, 0.f}; a1 = a0;
                    for (int s = 0; s < NKS; ++s) { const float* pr = PARTB + ((size_t)s * (LEFTTILES * 256) + (pp0 - MAINTILES * 256)) * 1024 + 512 * j + 8 * F.lane; a0 += *(const f32x4*)pr; a1 += *(const f32x4*)(pr + 4); } }
                if (pp1 >= MAINTILES * 256) { b0 = (f32x4){0.f, 0.f, 0.f, 0.f}; b1 = b0;
                    for (int s = 0; s < NKS; ++s) { const float* pr = PARTB + ((size_t)s * (LEFTTILES * 256) + (pp1 - MAINTILES * 256)) * 1024 + 512 * j + 8 * F.lane; b0 += *(const f32x4*)pr; b1 += *(const f32x4*)(pr + 4); } }
                v[2 * j] = (f32x4){ALPHA * hlo(xw.x), ALPHA * hhi(xw.x), ALPHA * hlo(xw.y), ALPHA * hhi(xw.y)} + a0 + b0;
                v[2 * j + 1] = (f32x4){ALPHA * hlo(xw.z), ALPHA * hhi(xw.z), ALPHA * hlo(xw.w), ALPHA * hhi(xw.w)} + a1 + b1; }
            float s = 0.f;
#pragma unroll
            for (int j = 0; j < 4; ++j) s += (v[j].x + v[j].y) + (v[j].z + v[j].w);
            const float mean = wave_sum(s) * (1.f / D); float s2 = 0.f;
#pragma unroll
            for (int j = 0; j < 4; ++j) { v[j] = v[j] - mean; s2 += (v[j].x * v[j].x + v[j].y * v[j].y) + (v[j].z * v[j].z + v[j].w * v[j].w); }
            const float rstd = 1.f / sqrtf(wave_sum(s2) * (1.f / D) + LN_EPS);
            asm volatile("" ::: "memory");
#pragma unroll
            for (int j = 0; j < 2; ++j) { f32x4 o0 = v[2 * j] * rstd * gq[2 * j] + bq[2 * j], o1 = v[2 * j + 1] * rstd * gq[2 * j + 1] + bq[2 * j + 1];
                if (bad) { const float qn = __builtin_nanf(""); o0 = (f32x4){qn, qn, qn, qn}; o1 = o0; }
                *(f32x4*)(out + (size_t)m * D + 512 * j + 8 * F.lane) = o0; *(f32x4*)(out + (size_t)m * D + 512 * j + 8 * F.lane + 4) = o1; }
#pragma unroll
            for (int j = 0; j < 2; ++j) { xwc[j] = xwn[j]; y0c[j] = y0n[j]; y1c[j] = y1n[j]; }
        }
#undef FIN_LOAD
    }
#undef MOE_WITEM
#undef IN
#undef GRID_BAR
#undef LN_PHASE
#undef LN_LOAD
#undef LN_MIX
#undef LN_STORE_H
#undef LN_STORE_Q8
#undef x_in
#undef w_qkv_a
#undef w_o_a
#undef w_kv_sh
#undef w_q_b
#undef w_o_b
#undef sinks_b
#undef w_gate_d
#undef w_up_d
#undef w_down_d
#undef w_router
#undef w_gate_e
#undef w_up_e
#undef w_down_e
#undef ln_gain
#undef ln_bias
#undef Wqkv_t
#undef Woa_t
#undef Wgud_t
#undef Wdd_t
#undef Wqb_t
#undef Wob_t
#undef Wgue8
#undef Wde8
#undef X8
#undef H8
#undef XB
#undef QB
#undef KB
#undef VB
#undef HB
#undef kmean
#undef rowtok
#undef rowpair
#undef roww
#undef re
#undef rwf
#undef cntg
#undef pairpos
#undef PARTB
#undef YP
#undef X1H
#undef X2H
#undef X3H
#undef ws
}

extern "C" void kernel_launch(void* const* d_in, const int* in_sizes, int n_in, void* d_out, int out_size, void* d_ws, size_t ws_size, hipStream_t stream) {
    static int grid = 0;
    if (grid == 0) {
        if (n_in != 16 || in_sizes[0] != T * D || out_size != T * D || ws_size < WS_END) { fprintf(stderr, "kernel_launch: unexpected shapes / workspace (n_in %d, ws %zu); nothing launched\n", n_in, ws_size); grid = -1; return; }
        int dev = 0, cus = 0, per_cu = 0;
        if (hipGetDevice(&dev) != hipSuccess || hipDeviceGetAttribute(&cus, hipDeviceAttributeMultiprocessorCount, dev) != hipSuccess) { grid = -1; return; }
        if (hipFuncSetAttribute((const void*)fwd_kernel, hipFuncAttributeMaxDynamicSharedMemorySize, LDS_BYTES) != hipSuccess) { fprintf(stderr, "kernel_launch: hipFuncSetAttribute failed\n"); grid = -1; return; }
        if (hipOccupancyMaxActiveBlocksPerMultiprocessor(&per_cu, (const void*)fwd_kernel, NWAVES * 64, LDS_BYTES) != hipSuccess || per_cu < 1) fprintf(stderr, "kernel_launch: occupancy query reports %d\n", per_cu);
        (void)hipGetLastError();
        grid = cus > 256 ? 256 : cus;
    }
    if (grid < 0) return;
    if (hipMemsetAsync((char*)d_ws + WS_CTL, 0, CTL_ZERO_BYTES, stream) != hipSuccess) return;
    Args a{};
    for (int i = 0; i < 16; ++i) a.in[i] = (const float*)d_in[i];
    a.out = (float*)d_out; a.ws = (unsigned char*)d_ws;
#if MK_ONE_LAUNCH
    a.ph_lo = 0; a.ph_hi = N_PHASES;
    hipLaunchKernelGGL(fwd_kernel, dim3(grid), dim3(NWAVES * 64), LDS_BYTES, stream, a);
#else
    for (int p = 0; p < N_PHASES; ++p) { a.ph_lo = p; a.ph_hi = p + 1; hipLaunchKernelGGL(fwd_kernel, dim3(grid), dim3(NWAVES * 64), LDS_BYTES, stream, a); }
#endif
}
```

```cpp
#include <hip/hip_runtime.h>
#include <cstdio>
#include <cstdint>

namespace pg8 {
#define PG8_LAS __attribute__((address_space(3)))
typedef unsigned short bf16_t;
typedef short bf16x8 __attribute__((ext_vector_type(8)));
typedef float f32x4 __attribute__((ext_vector_type(4)));
typedef unsigned u32x4 __attribute__((ext_vector_type(4)));
typedef int i32x4 __attribute__((ext_vector_type(4))); typedef int i32x8 __attribute__((ext_vector_type(8)));
constexpr int BM = 256, BK = 64, HALF = 128, HTB = HALF * BK * 2  , STAGE_BYTES = 8 * HTB, NXCD = 8, WGM = 8;

__host__ __device__ __forceinline__ int lds_byte(int r, int c) { const int st = (r >> 4) * 2 + (c >> 5), rr = r & 15, cc = c & 31, ob = rr * 64 + cc * 2; return st * 1024 + (ob ^ (((ob >> 9) & 1) << 5)); }
__host__ __device__ __forceinline__ void stage_rc(int b, int& R, int& C) { const int st = b / 1024, sb = b % 1024, swz = sb ^ (((sb >> 9) & 1) << 5); R = (st >> 1) * 16 + swz / 64; C = (st & 1) * 32 + (swz % 64) / 2; }
__host__ __device__ __forceinline__ int perm32(int rho) { const int n = rho >> 4, i = rho & 15; return 8 * (i >> 2) + 4 * n + (i & 3); }

struct Unit { int pm, pn, ks; };
struct Gemm { const bf16_t* A; const bf16_t* Bt; int K, lda, ldb; };

struct StaticOrder {
    int nM, nN, nwg, G, c;
    __device__ __forceinline__ void init(int nM_, int nN_, int G_, int c_) { nM = nM_; nN = nN_; nwg = nM * nN; G = G_; c = c_; }
    __device__ __forceinline__ bool next(int i, Unit& u) const {
        const long L = (long)i * G + c; if (L >= nwg) return false;
        int wgid = (int)L; { const int q = nwg / NXCD, r = nwg % NXCD, xcd = wgid % NXCD, off = wgid / NXCD; wgid = (xcd < r ? xcd * (q + 1) : r * (q + 1) + (xcd - r) * q) + off; }
        const int nig = WGM * nN, gid = wgid / nig, fm = gid * WGM, gsz = (nM - fm) < WGM ? (nM - fm) : WGM;
        u.pm = fm + ((wgid % nig) % gsz); u.pn = (wgid % nig) / gsz; return true;
    }
    __device__ __forceinline__ size_t b_off(const Unit&) const { return 0; }
    __device__ __forceinline__ size_t a_off(const Unit&) const { return 0; }
    __device__ __forceinline__ void a_ready(const Unit&) const {}
    __device__ __forceinline__ void done(const Unit&) const {}
};
struct MoeOrder {
    StaticOrder so; const PG8_LAS int* texp; size_t estride; const int* rows;
    __device__ __forceinline__ bool next(int i, Unit& u) const { return so.next(i, u); }
    __device__ __forceinline__ size_t b_off(const Unit& u) const { return (size_t)texp[u.pm] * estride; }
    __device__ __forceinline__ size_t a_off(const Unit&) const { return 0; }
    __device__ __forceinline__ void a_ready(const Unit&) const {}
    __device__ __forceinline__ void done(const Unit&) const {}
};

struct SplitOrder {
    int total, G, c, tile0, nks; const PG8_LAS int* texp; size_t estride; int kslice; const int* rows;
    __device__ __forceinline__ bool next(int i, Unit& u) const { const int idx = i * G + c; if (idx >= total) return false; const int q = idx / nks; u.ks = idx - q * nks; u.pm = tile0 + (q >> 2); u.pn = q & 3; return true; }
    __device__ __forceinline__ size_t b_off(const Unit& u) const { return (size_t)texp[u.pm] * estride + (size_t)u.ks * kslice; }
    __device__ __forceinline__ size_t a_off(const Unit& u) const { return (size_t)u.ks * kslice; }
    __device__ __forceinline__ void a_ready(const Unit&) const {}
    __device__ __forceinline__ void done(const Unit&) const {}
};
__device__ __forceinline__ unsigned cvt_pk_bf16(float lo, float hi) { unsigned r; asm volatile("v_cvt_pk_bf16_f32 %0, %1, %2" : "=v"(r) : "v"(lo), "v"(hi)); return r; }

__device__ __forceinline__ unsigned pk4_i8(float a, float b, float c, float d) {
    const int ia = (int)__builtin_rintf(__builtin_amdgcn_fmed3f(a, -127.f, 127.f)), ib = (int)__builtin_rintf(__builtin_amdgcn_fmed3f(b, -127.f, 127.f)), ic = (int)__builtin_rintf(__builtin_amdgcn_fmed3f(c, -127.f, 127.f)), id = (int)__builtin_rintf(__builtin_amdgcn_fmed3f(d, -127.f, 127.f));
    return ((unsigned)ia & 255u) | (((unsigned)ib & 255u) << 8) | (((unsigned)ic & 255u) << 16) | ((unsigned)id << 24); }
__device__ __forceinline__ f32x4 acc_i2f(f32x4 a) { const i32x4 i = __builtin_bit_cast(i32x4, a); return (f32x4){(float)i[0], (float)i[1], (float)i[2], (float)i[3]}; }
struct EpiBf16 {
    static constexpr bool PERM = true;
    bf16_t* O; int ldc; int split_cols; size_t split_stride; float scale0; float* kmean;
    __device__ __forceinline__ void operator()(const f32x4 (&acc)[2][2][4][2], const Unit& u, int wr, int wc, int fr, int fq) const {
        const int row0 = u.pm * BM + wr * 64 + fr; int colt = u.pn * BM; bf16_t* base = O;
        float sc = scale0; int tsel = 0; if (split_cols) { const int t = colt / split_cols; tsel = t; base += (size_t)t * split_stride; colt -= t * split_cols; if (t != 0) sc = 1.f; }
        const int col0 = colt + wc * 32 + 8 * fq;
        if (kmean != nullptr && tsel == 1) {
#pragma unroll
            for (int bj = 0; bj < 2; ++bj)
#pragma unroll
                for (int n = 0; n < 2; ++n) { f32x4 s = (f32x4){0.f, 0.f, 0.f, 0.f};
#pragma unroll
                    for (int ai = 0; ai < 2; ++ai)
#pragma unroll
                        for (int m = 0; m < 4; ++m) s += acc[ai][bj][m][n];
#pragma unroll
                    for (int j = 0; j < 4; ++j) { float v = s[j]; v += __shfl_xor(v, 1); v += __shfl_xor(v, 2); v += __shfl_xor(v, 4); v += __shfl_xor(v, 8);
                        if (fr == 0) { const int c = col0 + bj * HALF + 4 * n + j; atomicAdd(kmean + ((size_t)((u.pm >> 4) * 16 + (c >> 6)) * 16 + (u.pm & 15)) * 64 + (c & 63), v * (1.f / 256.f)); } } }
            asm volatile("" ::: "memory");
        }
#pragma unroll
        for (int ai = 0; ai < 2; ++ai)
#pragma unroll
            for (int m = 0; m < 4; ++m) { bf16_t* rowp = base + (size_t)(row0 + ai * HALF + m * 16) * ldc + col0;
#pragma unroll
                for (int bj = 0; bj < 2; ++bj) { f32x4 v0 = acc[ai][bj][m][0] * sc, v1 = acc[ai][bj][m][1] * sc;
                    u32x4 w; w.x = cvt_pk_bf16(v0[0], v0[1]); w.y = cvt_pk_bf16(v0[2], v0[3]); w.z = cvt_pk_bf16(v1[0], v1[1]); w.w = cvt_pk_bf16(v1[2], v1[3]);
                    *(u32x4*)(rowp + bj * HALF) = w; } }
    }
};
__device__ __forceinline__ float silu_mul_raw(float ga, float uc, float c1) { const float e = __builtin_amdgcn_exp2f(ga * c1); return (ga * __builtin_amdgcn_rcpf(1.0f + e)) * uc; }
__device__ __forceinline__ unsigned pk4_fp8(float a, float b, float c, float d) { int r = 0; r = __builtin_amdgcn_cvt_pk_fp8_f32(a, b, r, false); r = __builtin_amdgcn_cvt_pk_fp8_f32(c, d, r, true); return (unsigned)r; }
__device__ __forceinline__ float clamp448(float v) { return __builtin_amdgcn_fmed3f(v, -448.f, 448.f); }
template <bool ISINT> struct EpiSwigluF8 {
    static constexpr bool PERM = true;
    unsigned char* H; int ldh; float sc, hs;
    __device__ __forceinline__ void operator()(const f32x4 (&acc)[2][2][4][2], const Unit& u, int wr, int wc, int fr, int fq) const {
        const int row0 = u.pm * BM + wr * 64 + fr; const int col0 = u.pn * HALF + wc * 32 + 8 * fq;
        typedef unsigned u32x2 __attribute__((ext_vector_type(2)));
#pragma unroll
        for (int ai = 0; ai < 2; ++ai)
#pragma unroll
            for (int m = 0; m < 4; ++m) { unsigned char* rowp = H + (size_t)(row0 + ai * HALF + m * 16) * ldh + col0;
                const float c1 = -1.4426950408889634f * sc, c2 = sc * sc * hs;
                const f32x4 g0 = (ISINT ? acc_i2f(acc[ai][0][m][0]) : acc[ai][0][m][0]), g1 = (ISINT ? acc_i2f(acc[ai][0][m][1]) : acc[ai][0][m][1]), u0 = (ISINT ? acc_i2f(acc[ai][1][m][0]) : acc[ai][1][m][0]) * c2, u1 = (ISINT ? acc_i2f(acc[ai][1][m][1]) : acc[ai][1][m][1]) * c2;
                u32x2 w; w.x = pk4_fp8(clamp448(silu_mul_raw(g0[0], u0[0], c1)), clamp448(silu_mul_raw(g0[1], u0[1], c1)), clamp448(silu_mul_raw(g0[2], u0[2], c1)), clamp448(silu_mul_raw(g0[3], u0[3], c1)));
                w.y = pk4_fp8(clamp448(silu_mul_raw(g1[0], u1[0], c1)), clamp448(silu_mul_raw(g1[1], u1[1], c1)), clamp448(silu_mul_raw(g1[2], u1[2], c1)), clamp448(silu_mul_raw(g1[3], u1[3], c1)));
                *(u32x2*)rowp = w; }
    }
};
struct EpiMoeDown {
    static constexpr bool PERM = true;
    bf16_t* Y; const int* rowpair; const float* roww; float sc;
    __device__ __forceinline__ void operator()(const f32x4 (&acc)[2][2][4][2], const Unit& u, int wr, int wc, int fr, int fq) const {
        const int row0 = u.pm * BM + wr * 64 + fr; const int col0 = u.pn * BM + wc * 32 + 8 * fq;
        int pid[2][4]; float w[2][4];
#pragma unroll
        for (int ai = 0; ai < 2; ++ai)
#pragma unroll
            for (int m = 0; m < 4; ++m) { pid[ai][m] = rowpair[row0 + ai * HALF + m * 16]; w[ai][m] = roww[row0 + ai * HALF + m * 16] * sc; }
#pragma unroll
        for (int ai = 0; ai < 2; ++ai)
#pragma unroll
            for (int m = 0; m < 4; ++m) {
                if (pid[ai][m] >= 0) { bf16_t* rowp = Y + (size_t)pid[ai][m] * 1024 + col0;
#pragma unroll
                    for (int bj = 0; bj < 2; ++bj) { const f32x4 v0 = acc[ai][bj][m][0] * w[ai][m], v1 = acc[ai][bj][m][1] * w[ai][m];
                        u32x4 wv; wv.x = cvt_pk_bf16(v0[0], v0[1]); wv.y = cvt_pk_bf16(v0[2], v0[3]); wv.z = cvt_pk_bf16(v1[0], v1[1]); wv.w = cvt_pk_bf16(v1[2], v1[3]);
                        *(u32x4*)(rowp + bj * HALF) = wv; } } }
    }
};

struct EpiPartial {
    static constexpr bool PERM = false;
    float* P; const float* roww; float sc; int tile0, prow;
    __device__ __forceinline__ void operator()(const f32x4 (&acc)[2][2][4][2], const Unit& u, int wr, int wc, int fr, int fq) const {
        const int col0 = u.pn * BM + wc * 32 + 4 * fq;
#pragma unroll
        for (int ai = 0; ai < 2; ++ai)
#pragma unroll
            for (int m = 0; m < 4; ++m) { const int rl = ai * HALF + wr * 64 + m * 16 + fr; const float w = roww[u.pm * BM + rl] * sc;
                float* rp = P + ((size_t)u.ks * prow + (size_t)(u.pm - tile0) * BM + rl) * 1024 + col0;
#pragma unroll
                for (int bj = 0; bj < 2; ++bj)
#pragma unroll
                    for (int n = 0; n < 2; ++n) *(f32x4*)(rp + bj * HALF + n * 16) = acc[ai][bj][m][n] * w; }
    }
};

template <class Epi, class Sched, bool ALIGN_EPI, bool GATHER, int QT = 0>
__device__ __forceinline__ void gemm_phase(PG8_LAS unsigned char* lds, const Gemm g, const Sched& S, const Epi& E) {
    const int tid = threadIdx.x, wid = __builtin_amdgcn_readfirstlane(tid >> 6), lane = tid & 63, wr = wid >> 2, wc = wid & 3, fr = lane & 15, fq = lane >> 4;
    constexpr bool F8 = (QT == 1), I8 = (QT == 2), H16 = (QT == 3); constexpr int ESZ = (QT == 1 || QT == 2) ? 1 : 2;
    const int K = g.K, nt = K * ESZ / (BK * 2);
    unsigned voffB[2], vA0[2], vA1[2], vA0n[2], vA1n[2]; int Rr[2], Cc[2];
#pragma unroll
    for (int i = 0; i < 2; ++i) { int R, C; stage_rc(tid * 16 + i * 8192, R, C); const int Rb = Epi::PERM ? ((R & ~31) + perm32(R & 31)) : R; Rr[i] = R; Cc[i] = C;
        voffB[i] = (unsigned)(Rb * g.ldb) * ESZ + 2u * C; vA0[i] = (unsigned)(R * g.lda) * ESZ + 2u * C; vA1[i] = (unsigned)((R + HALF) * g.lda) * ESZ + 2u * C; vA0n[i] = vA0[i]; vA1n[i] = vA1[i]; }
    const size_t kstep = (size_t)(BK * 2);
    const size_t hstepB = (size_t)HALF * g.ldb * ESZ, tstepB = 2 * hstepB, tstepA = (size_t)BM * g.lda * ESZ;
    const unsigned ldsw = (unsigned)wid * 1024u;
    const int aoff = lds_byte(wr * 64 + fr, fq * 8), boff = lds_byte(wc * 32 + fr, fq * 8);
#define PG8_SA(b, h) (((b) * 2 + (h)) * HTB)
#define PG8_SB(b, h) ((4 + (b) * 2 + (h)) * HTB)
#define PG8_STAGE(bufoff, gbase, voff) do { _Pragma("unroll") for (int _i = 0; _i < 2; ++_i) \
        __builtin_amdgcn_global_load_lds((const unsigned*)((const char*)(gbase) + (voff)[_i]), (PG8_LAS unsigned*)(lds + (bufoff) + ldsw + _i * 8192), 16, 0, 0); } while (0)
#define PG8_LDA(dst, b, h) do { _Pragma("unroll") for (int m = 0; m < 4; ++m) { const i32x4 f0_ = *(const PG8_LAS i32x4*)(lds + PG8_SA(b, h) + aoff + m * 2048), f1_ = *(const PG8_LAS i32x4*)(lds + PG8_SA(b, h) + aoff + m * 2048 + 1024); \
        dst[m] = __builtin_shufflevector(f0_, f1_, 0, 1, 2, 3, 4, 5, 6, 7); } } while (0)
#define PG8_LDB(dst, b, h) do { _Pragma("unroll") for (int n = 0; n < 2; ++n) { const i32x4 f0_ = *(const PG8_LAS i32x4*)(lds + PG8_SB(b, h) + boff + n * 2048), f1_ = *(const PG8_LAS i32x4*)(lds + PG8_SB(b, h) + boff + n * 2048 + 1024); \
        dst[n] = __builtin_shufflevector(f0_, f1_, 0, 1, 2, 3, 4, 5, 6, 7); } } while (0)
#define PG8_LO4(v) ((i32x4)__builtin_shufflevector(v, v, 0, 1, 2, 3))
#define PG8_HI4(v) ((i32x4)__builtin_shufflevector(v, v, 4, 5, 6, 7))
#define PG8_MMA(ai, bj, At, Bt) do { __builtin_amdgcn_s_setprio(1); _Pragma("unroll") for (int n = 0; n < 2; ++n) _Pragma("unroll") for (int m = 0; m < 4; ++m) { \
        if constexpr (F8) asm volatile("v_mfma_scale_f32_16x16x128_f8f6f4 %0, %1, %2, %0, %3, %3 op_sel_hi:[0,0,0]" : "+v"(acc[ai][bj][m][n]) : "v"(Bt[n]), "v"(At[m]), "v"(scl1));   \
        else if constexpr (I8) { asm volatile("v_mfma_i32_16x16x64_i8 %0, %1, %2, %0" : "+v"(acc[ai][bj][m][n]) : "v"(PG8_LO4(Bt[n])), "v"(PG8_LO4(At[m]))); asm volatile("v_mfma_i32_16x16x64_i8 %0, %1, %2, %0" : "+v"(acc[ai][bj][m][n]) : "v"(PG8_HI4(Bt[n])), "v"(PG8_HI4(At[m]))); } \
        else if constexpr (H16) { asm volatile("v_mfma_f32_16x16x32_f16 %0, %1, %2, %0" : "+v"(acc[ai][bj][m][n]) : "v"(PG8_LO4(Bt[n])), "v"(PG8_LO4(At[m]))); asm volatile("v_mfma_f32_16x16x32_f16 %0, %1, %2, %0" : "+v"(acc[ai][bj][m][n]) : "v"(PG8_HI4(Bt[n])), "v"(PG8_HI4(At[m]))); } \
        else { asm volatile("v_mfma_f32_16x16x32_bf16 %0, %1, %2, %0" : "+v"(acc[ai][bj][m][n]) : "v"(PG8_LO4(Bt[n])), "v"(PG8_LO4(At[m]))); asm volatile("v_mfma_f32_16x16x32_bf16 %0, %1, %2, %0" : "+v"(acc[ai][bj][m][n]) : "v"(PG8_HI4(Bt[n])), "v"(PG8_HI4(At[m]))); } } __builtin_amdgcn_s_setprio(0); } while (0)
#define PG8_WAIT_V(n) asm volatile("s_waitcnt vmcnt(" #n ")" ::: "memory")
#define PG8_WAIT_L(n) asm volatile("s_waitcnt lgkmcnt(" #n ")" ::: "memory")
#define PG8_BAR __builtin_amdgcn_s_barrier()
#define PG8_SCHED __builtin_amdgcn_sched_barrier(0)
#define PG8_GROWS(u, v0, v1) do { const int* rp_ = S.rows + (size_t)(u).pm * BM; _Pragma("unroll") for (int i_ = 0; i_ < 2; ++i_) { \
        const unsigned r0_ = (unsigned)rp_[Rr[i_]], r1_ = (unsigned)rp_[HALF + Rr[i_]]; v0[i_] = r0_ * (unsigned)g.lda * ESZ + 2u * (unsigned)Cc[i_]; v1[i_] = r1_ * (unsigned)g.lda * ESZ + 2u * (unsigned)Cc[i_]; \
        asm volatile("" : "+v"(v0[i_]), "+v"(v1[i_])); } } while (0)
    Unit cur, nxt; int ui = 0;
    if (!S.next(0, cur)) return;
    f32x4 acc[2][2][4][2];
#pragma unroll
    for (int a = 0; a < 2; ++a)
#pragma unroll
        for (int b = 0; b < 2; ++b)
#pragma unroll
            for (int m = 0; m < 4; ++m)
#pragma unroll
                for (int n = 0; n < 2; ++n) acc[a][b][m][n] = (f32x4){0.f, 0.f, 0.f, 0.f};
    i32x8 At[4], B0[2], B1[2]; int scl1 = 0x7f7f7f7f; asm volatile("" : "+v"(scl1));
    const char* cA = (const char*)g.A + (GATHER ? (size_t)0 : (size_t)cur.pm * tstepA) + S.a_off(cur); const char* cB = (const char*)g.Bt + S.b_off(cur) + (size_t)cur.pn * tstepB;
    if constexpr (GATHER) { PG8_GROWS(cur, vA0, vA1); }
    S.a_ready(cur);
    PG8_STAGE(PG8_SB(0, 0), cB, voffB); PG8_STAGE(PG8_SB(0, 1), cB + hstepB, voffB); PG8_STAGE(PG8_SA(0, 0), cA, vA0); PG8_STAGE(PG8_SA(0, 1), cA, vA1);
    if (wr == 1) PG8_BAR;
    PG8_WAIT_V(2); PG8_BAR;
    PG8_STAGE(PG8_SB(1, 0), cB + kstep, voffB); PG8_STAGE(PG8_SA(1, 0), cA + kstep, vA0); PG8_STAGE(PG8_SB(1, 1), cB + hstepB + kstep, voffB);
    PG8_WAIT_V(6); PG8_BAR;
    for (;;) {
        const bool has_next = S.next(ui + 1, nxt);
        const char* nA = (has_next && !GATHER) ? (const char*)g.A + (size_t)nxt.pm * tstepA + S.a_off(nxt) : cA; const char* nB = has_next ? (const char*)g.Bt + S.b_off(nxt) + (size_t)nxt.pn * tstepB : cB;
        if constexpr (GATHER) { if (has_next) { PG8_GROWS(nxt, vA0n, vA1n); } else {
#pragma unroll
            for (int i = 0; i < 2; ++i) { vA0n[i] = vA0[i]; vA1n[i] = vA1[i]; } } }
#define PG8_PTRS(t) const bool last = ((t) == nt - 2); const char* a1 = cA + (size_t)((t) + 1) * kstep; \
            const char* a2 = last ? nA : cA + (size_t)((t) + 2) * kstep; const char* b2 = last ? nB : cB + (size_t)((t) + 2) * kstep; \
            const char* a3 = a2 + kstep; const char* b3 = b2 + kstep; unsigned x0[2], x1[2]; \
            _Pragma("unroll") for (int i = 0; i < 2; ++i) { x0[i] = (GATHER && last) ? vA0n[i] : vA0[i]; x1[i] = (GATHER && last) ? vA1n[i] : vA1[i]; }
#define PG8_TRIP(WV, STG1) do { \
            PG8_LDB(B0, 0, 0); PG8_LDB(B1, 0, 1); PG8_SCHED; PG8_LDA(At, 0, 0); if (STG1) { PG8_STAGE(PG8_SA(1, 1), a1, vA1); } \
            PG8_WAIT_V(WV); PG8_WAIT_L(0); PG8_BAR; PG8_MMA(0, 0, At, B0); PG8_MMA(0, 1, At, B1); PG8_BAR; PG8_SCHED; \
            PG8_LDA(At, 0, 1); PG8_STAGE(PG8_SB(0, 0), b2, voffB); PG8_STAGE(PG8_SB(0, 1), b2 + hstepB, voffB); PG8_STAGE(PG8_SA(0, 0), a2, x0); \
            PG8_WAIT_V(WV); PG8_WAIT_L(0); PG8_BAR; PG8_MMA(1, 0, At, B0); PG8_MMA(1, 1, At, B1); PG8_BAR; PG8_SCHED; \
            PG8_LDB(B0, 1, 0); PG8_LDB(B1, 1, 1); PG8_SCHED; PG8_LDA(At, 1, 0); PG8_STAGE(PG8_SA(0, 1), a2, x1); \
            PG8_WAIT_V(WV); PG8_WAIT_L(0); PG8_BAR; PG8_MMA(0, 0, At, B0); PG8_MMA(0, 1, At, B1); PG8_BAR; PG8_SCHED; \
            PG8_LDA(At, 1, 1); PG8_STAGE(PG8_SB(1, 0), b3, voffB); PG8_STAGE(PG8_SB(1, 1), b3 + hstepB, voffB); PG8_STAGE(PG8_SA(1, 0), a3, x0); \
            PG8_WAIT_V(8); PG8_WAIT_L(0); PG8_BAR; PG8_MMA(1, 0, At, B0); PG8_MMA(1, 1, At, B1); PG8_BAR; PG8_SCHED; } while (0)
        for (int t = 0; t < nt; t += 2) { PG8_PTRS(t) PG8_TRIP(8, true); }
#undef PG8_TRIP
#undef PG8_PTRS
        if constexpr (ALIGN_EPI) { if (wr == 0) PG8_BAR; }
        asm volatile("s_nop 15\n\ts_nop 7" ::: "memory");
        E(acc, cur, wr, wc, fr, fq); S.done(cur);
        if (!has_next) break;
#pragma unroll
        for (int a = 0; a < 2; ++a)
#pragma unroll
            for (int b = 0; b < 2; ++b)
#pragma unroll
                for (int m = 0; m < 4; ++m)
#pragma unroll
                    for (int n = 0; n < 2; ++n) acc[a][b][m][n] = (f32x4){0.f, 0.f, 0.f, 0.f};
        cur = nxt; cA = nA; cB = nB; ++ui;
        if constexpr (GATHER) {
#pragma unroll
            for (int i = 0; i < 2; ++i) { vA0[i] = vA0n[i]; vA1[i] = vA1n[i]; } }
        if constexpr (ALIGN_EPI) { if (wr == 1) PG8_BAR; }
    }
    PG8_WAIT_V(0);
    if constexpr (!ALIGN_EPI) { if (wr == 0) PG8_BAR; }
    PG8_BAR;
#undef PG8_SA
#undef PG8_SB
#undef PG8_STAGE
#undef PG8_LDA
#undef PG8_LDB
#undef PG8_MMA
#undef PG8_WAIT_V
#undef PG8_WAIT_L
#undef PG8_BAR
#undef PG8_SCHED
#undef PG8_GROWS
#undef PG8_LO4
#undef PG8_HI4
}
}

constexpr int NWAVES = 8;
constexpr int BATCH = 8, SEQ = 4096, D = 1024, NH = 16, HD = 64, T = BATCH * SEQ;
constexpr int FFD = 2816, FFE = 3584, NE = 8;
constexpr int MB = 256, NBLK = SEQ / MB;
constexpr int SW = 128;
constexpr float LN_EPS = 1e-5f;
constexpr float ALPHA = 1.4142135623730951f;
constexpr float LOG2E = 1.4426950408889634f;
constexpr float C2 = 0.125f * LOG2E;
constexpr float XSC = 20.f, WSC_GU = 1280.f, HSC = 32.f, WSC_D = 2048.f;
constexpr int MAXTILES = 264;
constexpr int MAXROWS = MAXTILES * 256;

constexpr size_t MiB = 1u << 20, KiB = 1u << 10;
constexpr size_t WS_CTL = 0, CTL_ZERO_BYTES = 64 * 1024;
constexpr size_t WS_ROUTE = 1 * MiB;
constexpr size_t WS_WQKV = 2 * MiB, WS_WOA = 8 * MiB, WS_WGUD = 10 * MiB, WS_WDD = 21 * MiB, WS_WQB = 27 * MiB, WS_WOB = 30 * MiB;
constexpr size_t WS_WGUE = 32 * MiB;
constexpr size_t WS_WDE = 88 * MiB;
constexpr size_t WS_XB = 200 * MiB;
constexpr size_t WS_Q = 264 * MiB, WS_K = 328 * MiB, WS_V = 392 * MiB;
constexpr size_t WS_H = 264 * MiB;
constexpr size_t WS_X8 = 116 * MiB;
constexpr size_t WS_KMEAN = 496 * MiB;
constexpr size_t WS_END = 500 * MiB;
static_assert(WS_WQKV + (size_t)3 * D * D * 2 <= WS_WOA && WS_WOA + (size_t)D * D * 2 <= WS_WGUD && WS_WGUD + (size_t)2 * FFD * D * 2 <= WS_WDD && WS_WDD + (size_t)FFD * D * 2 <= WS_WQB &&
              WS_WQB + (size_t)1280 * D * 2 <= WS_WOB && WS_WOB + (size_t)D * D * 2 <= WS_WGUE && WS_WGUE + (size_t)NE * 2 * FFE * D <= WS_WDE && WS_WDE + (size_t)NE * FFE * D <= WS_X8 && WS_X8 + (size_t)T * D <= WS_XB, "weights map");
static_assert(WS_H + (size_t)MAXROWS * FFE <= WS_KMEAN && WS_H + (size_t)T * FFD * 2 <= WS_KMEAN, "h map");
constexpr size_t R_ROWTOK = WS_ROUTE + 0;
constexpr size_t R_ROWPAIR = WS_ROUTE + 272 * KiB;
constexpr size_t R_ROWW = WS_ROUTE + 544 * KiB;
constexpr size_t R_RE = WS_ROUTE + 816 * KiB;
constexpr size_t R_CNT = WS_ROUTE + 944 * KiB;
constexpr size_t R_RWF = WS_KMEAN + 640 * KiB;
constexpr size_t R_PPOS = WS_KMEAN + 896 * KiB;
constexpr int MAINTILES = 256, LEFTTILES = MAXTILES - MAINTILES, NKS = 7, KSLICE = FFE / NKS;
constexpr size_t WS_PART = WS_X8;
static_assert(WS_PART + (size_t)NKS * LEFTTILES * 256 * 1024 * 4 <= WS_XB && R_PPOS + (size_t)2 * T * 4 <= WS_END && KSLICE % 256 == 0, "split-K partials map");
static_assert((size_t)MAXROWS * 4 <= 272 * KiB && R_CNT + 8 * KiB <= 2 * MiB && R_RWF + (size_t)T * 8 <= WS_END, "route map");

constexpr int RING_BYTES = 131072;
constexpr int MISC_OFF = RING_BYTES;
constexpr int LDS_BYTES = 147456;
constexpr int MW_BAR = 0;
constexpr int MW_START = 16;
constexpr int MW_TOTAL = 32;
constexpr int MW_NTILES = 48;
constexpr int MW_CBASE = 52;
constexpr int MW_TEXP = 64;
constexpr int MW_CNT = 512;
constexpr int MW_SPAIR = 2560;
static_assert(MW_SPAIR + 256 <= 4096 && MW_TEXP + MAXTILES <= MW_CNT, "MISC map");

#define GAS __attribute__((address_space(1)))
#define LAS __attribute__((address_space(3)))
typedef unsigned short bf16;
typedef unsigned v4u __attribute__((ext_vector_type(4)));
typedef float f32x4 __attribute__((ext_vector_type(4)));
typedef GAS unsigned gu32;
#define RLX_AGENT __ATOMIC_RELAXED, __HIP_MEMORY_SCOPE_AGENT
#define LDS_WAIT() asm volatile("s_waitcnt lgkmcnt(0)" ::: "memory")
#define VM_WAIT() asm volatile("s_waitcnt vmcnt(0)" ::: "memory")
__device__ __forceinline__ unsigned f2bf(float f) { unsigned u = __builtin_bit_cast(unsigned, f); return (u + 0x7fffu + ((u >> 16) & 1u)) >> 16; }
__device__ __forceinline__ unsigned pk2(float lo, float hi) { return f2bf(lo) | (f2bf(hi) << 16); }
typedef _Float16 h16x2 __attribute__((ext_vector_type(2)));
__device__ __forceinline__ unsigned pkh2(float lo, float hi) { const h16x2 v = {(_Float16)lo, (_Float16)hi}; return __builtin_bit_cast(unsigned, v); }
__device__ __forceinline__ float hlo(unsigned w) { return (float)__builtin_bit_cast(h16x2, w)[0]; }
__device__ __forceinline__ float hhi(unsigned w) { return (float)__builtin_bit_cast(h16x2, w)[1]; }
__device__ __forceinline__ float bflo(unsigned w) { return __uint_as_float(w << 16); }
__device__ __forceinline__ float bfhi(unsigned w) { return __uint_as_float(w & 0xffff0000u); }

#define XB_TMO      128
#define XB_XCNT(j)  (256  + 64 * (j))
#define XB_XSUB(j)  (1280 + 64 * (j))
#define XB_XGEN(j)  (2304 + 64 * (j))
#define XB_TOP      3328
#define XB_TOPGEN   3392
#define XCD_BAR_WORDS 3456
#define XB_SPIN_CAP (1u << 22)
__device__ __forceinline__ unsigned xb_ld(unsigned* p)              { return __hip_atomic_load(p, __ATOMIC_RELAXED, __HIP_MEMORY_SCOPE_AGENT); }
__device__ __forceinline__ unsigned xb_add(unsigned* p, unsigned v) { return __hip_atomic_fetch_add(p, v, __ATOMIC_RELAXED, __HIP_MEMORY_SCOPE_AGENT); }
__device__ __forceinline__ unsigned xb_xcc_id() { return (unsigned)__builtin_amdgcn_s_getreg((3 << 11) | 20) & 0xFu; }
#define XB_SPIN(cond, bar) do { unsigned _sp = 0; while (cond) { __builtin_amdgcn_s_sleep(1); \
    if ((++_sp & 255u) == 0u) { if (xb_ld(&(bar)[XB_TMO])) break; if (_sp > XB_SPIN_CAP) { atomicAdd(&(bar)[XB_TMO], 1u); break; } } } } while (0)
struct XcdBarrier { unsigned* bar; unsigned x; volatile LAS unsigned* st; };
__device__ __forceinline__ XcdBarrier xcd_barrier_post(unsigned* bar, volatile LAS unsigned* st) {
    XcdBarrier b; b.bar = bar; b.x = xb_xcc_id(); b.st = st;
    if (threadIdx.x == 0) (void)xb_add(&bar[XB_XCNT(b.x)], 1u);
    return b;
}
__device__ __forceinline__ void xcd_barrier_complete(unsigned* bar, unsigned x, unsigned& nloc, unsigned& nx) {
    const unsigned G = gridDim.x * gridDim.y * gridDim.z;
    unsigned sum, cnt, mine, sp = 0u;
    for (;;) {
        sum = 0u; cnt = 0u; mine = 0u;
#pragma unroll
        for (unsigned j = 0; j < 16; ++j) { const unsigned c = xb_ld(&bar[XB_XCNT(j)]); sum += c; cnt += (c > 0u) ? 1u : 0u; mine = (j == x) ? c : mine; }
        if (sum == G) break;
        __builtin_amdgcn_s_sleep(1);
        if ((++sp & 255u) == 0u) { if (xb_ld(&bar[XB_TMO])) break; if (sp > XB_SPIN_CAP) { atomicAdd(&bar[XB_TMO], 1u); break; } }
    }
    nloc = mine > 0u ? mine : 1u; nx = cnt > 0u ? cnt : 1u;
}
__device__ __forceinline__ void xcd_barrier(const XcdBarrier& b) {
    asm volatile("s_waitcnt vmcnt(0)" ::: "memory");
    __syncthreads();
    if (threadIdx.x == 0) {
        unsigned* bar = b.bar;
        __builtin_amdgcn_s_waitcnt(0);
        unsigned nloc = b.st[0], nx = b.st[1];
        if (nloc == 0u) { xcd_barrier_complete(bar, b.x, nloc, nx); b.st[0] = nloc; b.st[1] = nx; }
        const unsigned old = xb_add(&bar[XB_XSUB(b.x)], 1u);
        const unsigned gen = old / nloc;
        if (old + 1u == (gen + 1u) * nloc) {
            __builtin_amdgcn_fence(__ATOMIC_RELEASE, "agent");
            asm volatile("s_waitcnt vmcnt(0)" ::: "memory");
            const unsigned og = xb_add(&bar[XB_TOP], 1u);
            const unsigned tg = og / nx;
            if (og + 1u == (tg + 1u) * nx) xb_add(&bar[XB_TOPGEN], 1u);
            else XB_SPIN(xb_ld(&bar[XB_TOPGEN]) == tg, bar);
            __builtin_amdgcn_fence(__ATOMIC_ACQUIRE, "agent");
            xb_add(&bar[XB_XGEN(b.x)], 1u);
            asm volatile("s_waitcnt vmcnt(0)" ::: "memory");
        } else {
            XB_SPIN(xb_ld(&bar[XB_XGEN(b.x)]) == gen, bar);
            __builtin_amdgcn_fence(__ATOMIC_ACQUIRE, "agent");
            asm volatile("s_waitcnt vmcnt(0)" ::: "memory");
        }
    }
    __syncthreads();
}

struct Frame {
    LAS unsigned char* lds;
    volatile LAS unsigned* MISC;
    gu32* ctl;
    unsigned char* ws;
    int tid, lane, wave, G;
};
constexpr int CW_BAR = 1024;
static_assert((CW_BAR + XCD_BAR_WORDS) * 4 <= (int)CTL_ZERO_BYTES, "CTL words inside the memset region");

__device__ __forceinline__ float wave_sum(float v) {
#pragma unroll
    for (int o = 1; o < 64; o <<= 1) v += __shfl_xor(v, o);
    return v;
}
template <bool H16 = false> __device__ __forceinline__ void tr_item(const float* W, int ldw, int k0, int n0, bf16* dst, int ldt, LAS float* scr, int lane) {
#pragma unroll 8
    for (int i = 0; i < 32; ++i) { const int kk = 2 * i + (lane >> 5); scr[kk * 33 + (lane & 31)] = W[(size_t)(k0 + kk) * ldw + n0 + (lane & 31)]; }
    LDS_WAIT(); asm volatile("" ::: "memory");
    const int c = lane & 7;
#pragma unroll
    for (int j = 0; j < 4; ++j) { const int n = (lane >> 3) + 8 * j; const LAS float* s = scr + (8 * c) * 33 + n;
        v4u o; if (H16) { o.x = pkh2(s[0 * 33], s[1 * 33]); o.y = pkh2(s[2 * 33], s[3 * 33]); o.z = pkh2(s[4 * 33], s[5 * 33]); o.w = pkh2(s[6 * 33], s[7 * 33]); }
        else { o.x = pk2(s[0 * 33], s[1 * 33]); o.y = pk2(s[2 * 33], s[3 * 33]); o.z = pk2(s[4 * 33], s[5 * 33]); o.w = pk2(s[6 * 33], s[7 * 33]); }
        *(GAS v4u*)(dst + (size_t)n * ldt + 8 * c) = o; }
    LDS_WAIT(); asm volatile("" ::: "memory");
}
template <bool I8> __device__ __forceinline__ void tr_item8(const float* W, int ldw, int k0, int n0, unsigned char* dst, int ldt, float scale, LAS float* scr, int lane) {
    float wv_[32];
#pragma unroll
    for (int i = 0; i < 32; ++i) wv_[i] = W[(size_t)(k0 + 2 * i + (lane >> 5)) * ldw + n0 + (lane & 31)];
#pragma unroll
    for (int i = 0; i < 32; ++i) scr[(2 * i + (lane >> 5)) * 33 + (lane & 31)] = wv_[i];
    LDS_WAIT(); asm volatile("" ::: "memory");
    const int c = lane & 7; typedef unsigned u32x2 __attribute__((ext_vector_type(2)));
#pragma unroll
    for (int j = 0; j < 4; ++j) { const int n = (lane >> 3) + 8 * j; const LAS float* s = scr + (8 * c) * 33 + n;
        u32x2 o; if (I8) { o.x = pg8::pk4_i8(s[0 * 33] * scale, s[1 * 33] * scale, s[2 * 33] * scale, s[3 * 33] * scale); o.y = pg8::pk4_i8(s[4 * 33] * scale, s[5 * 33] * scale, s[6 * 33] * scale, s[7 * 33] * scale); }
        else { o.x = pg8::pk4_fp8(s[0 * 33] * scale, s[1 * 33] * scale, s[2 * 33] * scale, s[3 * 33] * scale); o.y = pg8::pk4_fp8(s[4 * 33] * scale, s[5 * 33] * scale, s[6 * 33] * scale, s[7 * 33] * scale); }
        *(GAS u32x2*)(dst + (size_t)n * ldt + 8 * c) = o; }
    LDS_WAIT(); asm volatile("" ::: "memory");
}
template <bool I8> __device__ __forceinline__ void tr_job8(const float* W, int K, int N, unsigned char* WT, int ldt, int mode, float scale, LAS float* scr, int r, int lane) {
    const int nblk = N / 32, kb = r / nblk, nb = r % nblk, k0 = 64 * kb, n0 = 32 * nb;
    const int row = (mode == 0) ? n0 : ((n0 >> 7) * 256 + (mode - 1) * 128 + (n0 & 127));
    tr_item8<I8>(W, N, k0, n0, WT + (size_t)row * ldt + k0, ldt, scale, scr, lane);
}
template <bool H16 = false> __device__ __forceinline__ void tr_job(const float* W, int K, int N, bf16* WT, int ldt, int mode, int row_off, LAS float* scr, int r, int lane) {
    const int nblk = N / 32, kb = r / nblk, nb = r % nblk, k0 = 64 * kb, n0 = 32 * nb;
    const int row = (mode == 0) ? (row_off + n0) : ((n0 >> 7) * 256 + (mode - 1) * 128 + (n0 & 127));
    tr_item<H16>(W, N, k0, n0, WT + (size_t)row * ldt + k0, ldt, scr, lane);
}

struct Args { const float* in[16]; float* out; unsigned char* ws; int ph_lo, ph_hi; };

struct LnPar { f32x4 g[4], b[4]; };
__device__ __forceinline__ void ln_load_par(LnPar& P, const float* gain, const float* bias, int lane) {
#pragma unroll
    for (int j = 0; j < 4; ++j) { P.g[j] = *(const f32x4*)(gain + 256 * j + 4 * lane); P.b[j] = *(const f32x4*)(bias + 256 * j + 4 * lane); }
}
__device__ __forceinline__ void ln_row(f32x4 (&v)[4], const LnPar& P) {
    float s = 0.f;
#pragma unroll
    for (int j = 0; j < 4; ++j) s += (v[j].x + v[j].y) + (v[j].z + v[j].w);
    const float mean = wave_sum(s) * (1.f / D); float s2 = 0.f;
#pragma unroll
    for (int j = 0; j < 4; ++j) { v[j] = v[j] - mean; s2 += (v[j].x * v[j].x + v[j].y * v[j].y) + (v[j].z * v[j].z + v[j].w * v[j].w); }
    const float rstd = 1.f / sqrtf(wave_sum(s2) * (1.f / D) + LN_EPS);
#pragma unroll
    for (int j = 0; j < 4; ++j) v[j] = v[j] * rstd * P.g[j] + P.b[j];
}
__device__ __forceinline__ void route_tables(Frame& F, const int* cntg) {
    __syncthreads();
    for (int i = F.tid; i < 256 * NE; i += NWAVES * 64) F.MISC[MW_CNT + i] = (unsigned)cntg[i];
    __syncthreads();
    if (F.tid < NE) { unsigned s = 0; for (int c = 0; c < 256; ++c) s += F.MISC[MW_CNT + c * NE + F.tid]; F.MISC[MW_TOTAL + F.tid] = s; }
    __syncthreads();
    if (F.tid == 0) { unsigned st = 0;
        for (int e = 0; e < NE; ++e) { F.MISC[MW_START + e] = st; const unsigned nt_ = (F.MISC[MW_TOTAL + e] + 255u) >> 8; for (unsigned i = 0; i < nt_; ++i) F.MISC[MW_TEXP + (st >> 8) + i] = (unsigned)e; st += nt_ << 8; }
        F.MISC[MW_START + NE] = st; F.MISC[MW_NTILES] = st >> 8; }
    __syncthreads();
}

#include <hip/hip_bf16.h>
#include <cmath>
namespace mattn {
using bf16=__hip_bfloat16;
using bf16x8=__attribute__((ext_vector_type(8)))short;
using s16x4=__attribute__((ext_vector_type(4)))short;
using f32x16=__attribute__((ext_vector_type(16)))float;
using u32x4=__attribute__((ext_vector_type(4)))unsigned;
constexpr int BATCH=8,NHEAD=16,SEQ=4096,D=64,DM=NHEAD*D;
constexpr int NW=8,QBLK=32,QB=QBLK*NW,KVBLK=64,NQB=SEQ/QB;
constexpr int ATTN_PITCH=DM, ATTN_UNIT_ROWS=QB;
__device__ __forceinline__ int crow(int r,int hi){return (r&3)+8*(r>>2)+4*hi;}
#define SBAR() __builtin_amdgcn_sched_barrier(0)
__device__ __forceinline__ void cmask(f32x16&p0,f32x16&p1,int jb,int qrel,int hi){
  const float NEG=-INFINITY; int kb=64*jb+4*hi;
  #pragma unroll
  for(int r=0;r<16;++r){int kv=kb+(r&3)+8*(r>>2); if(kv>qrel)p0[r]=NEG; if(kv+32>qrel)p1[r]=NEG;}
}

constexpr int NSLOT=3, SLOTB=8192;
constexpr int LDS_K=0, LDS_V=NSLOT*SLOTB, LDS_WS=2*NSLOT*SLOTB, LDS_OST=LDS_WS+NW*64*4, LDS_KM=LDS_OST+NW*4096, LDS_BYTES=LDS_KM+4096;
constexpr float C2=0.125f*1.4426950408889634f;
__device__ __forceinline__ void glds16(const void*gsrc,unsigned lds_dst){unsigned keep;
  asm volatile("s_mov_b32 %0, m0\n\ts_mov_b32 m0, %2\n\ts_nop 0\n\tglobal_load_lds_dwordx4 %1, off\n\ts_mov_b32 m0, %0":"=&s"(keep):"v"(gsrc),"s"(lds_dst):"memory");}
__device__ __forceinline__ float max3f(float a,float b,float c){float r;asm("v_max3_f32 %0, %1, %2, %3":"=v"(r):"v"(a),"v"(b),"v"(c));return r;}
__device__ __forceinline__ float max2f(float a,float b){float r;asm("v_max_f32_e32 %0, %1, %2":"=v"(r):"v"(a),"v"(b));return r;}
__device__ __forceinline__ float fadd_s(float a,float b){float r;asm("v_add_f32_e32 %0, %1, %2":"=v"(r):"v"(a),"v"(b));return r;}
__device__ __forceinline__ float fsub_s(float a,float b){float r;asm("v_sub_f32_e32 %0, %1, %2":"=v"(r):"v"(a),"v"(b));return r;}
typedef float f32x2_t __attribute__((ext_vector_type(2))); typedef __bf16 bf16x2_t __attribute__((ext_vector_type(2)));
__device__ __forceinline__ unsigned cvtpk_s(float lo,float hi){f32x2_t v={lo,hi};bf16x2_t b=__builtin_convertvector(v,bf16x2_t);return __builtin_bit_cast(unsigned,b);}
#define WAIT_BAR(N) asm volatile("s_waitcnt vmcnt(" #N ") lgkmcnt(0)\n\ts_barrier":::"memory")

__device__ __forceinline__ void qkt(f32x16&p0,f32x16&p1,const char*Kslot,const bf16x8*qr,const bf16x8&kx0,const bf16x8&kx1,const bf16x8&qx,int r32,int hi){
  const char*kb=Kslot+hi*1024+r32*16;
  #pragma unroll
  for(int d0=0;d0<4;++d0){
    const bf16x8 b0=*reinterpret_cast<const bf16x8*>(kb+d0*2048);
    const bf16x8 b1=*reinterpret_cast<const bf16x8*>(kb+d0*2048+512);
    if(d0==0){p0=__builtin_amdgcn_mfma_f32_32x32x16_bf16(b0,qr[0],f32x16{},0,0,0);p1=__builtin_amdgcn_mfma_f32_32x32x16_bf16(b1,qr[0],f32x16{},0,0,0);}
    else{p0=__builtin_amdgcn_mfma_f32_32x32x16_bf16(b0,qr[d0],p0,0,0,0);p1=__builtin_amdgcn_mfma_f32_32x32x16_bf16(b1,qr[d0],p1,0,0,0);}}
  p0=__builtin_amdgcn_mfma_f32_32x32x16_bf16(kx0,qx,p0,0,0,0);p1=__builtin_amdgcn_mfma_f32_32x32x16_bf16(kx1,qx,p1,0,0,0);
}
__device__ __forceinline__ unsigned bfb(float f){unsigned u=__float_as_uint(f);return (u+0x7fffu+((u>>16)&1u))>>16;}
__device__ __forceinline__ void split3(float x,unsigned&h,unsigned&m,unsigned&l){h=bfb(x);const float r1=x-__uint_as_float(h<<16);m=bfb(r1);const float r2=r1-__uint_as_float(m<<16);l=bfb(r2);}
typedef __attribute__((address_space(3))) const char* lds_cptr;
typedef short v4i16_t __attribute__((ext_vector_type(4)));
__device__ __forceinline__ void kload8(bf16x8*kf,lds_cptr kp){
  kf[0]=*(const __attribute__((address_space(3))) bf16x8*)(kp);      kf[1]=*(const __attribute__((address_space(3))) bf16x8*)(kp+512);
  kf[2]=*(const __attribute__((address_space(3))) bf16x8*)(kp+2048); kf[3]=*(const __attribute__((address_space(3))) bf16x8*)(kp+2560);
  kf[4]=*(const __attribute__((address_space(3))) bf16x8*)(kp+4096); kf[5]=*(const __attribute__((address_space(3))) bf16x8*)(kp+4608);
  kf[6]=*(const __attribute__((address_space(3))) bf16x8*)(kp+6144); kf[7]=*(const __attribute__((address_space(3))) bf16x8*)(kp+6656);
}
__device__ __forceinline__ void kload2(bf16x8*kf,lds_cptr kp,int j){ kf[2*j]=*(const __attribute__((address_space(3))) bf16x8*)(kp+j*2048); kf[2*j+1]=*(const __attribute__((address_space(3))) bf16x8*)(kp+j*2048+512); }
__device__ __forceinline__ s16x4 vtr(lds_cptr p){ return __builtin_bit_cast(s16x4,__builtin_amdgcn_ds_read_tr16_b64_v4i16((__attribute__((address_space(3))) v4i16_t*)p)); }
__device__ __forceinline__ float rowmax(const f32x16&p0,const f32x16&p1){
  float a=max3f(p0[0],p0[1],p1[0]),b=max3f(p0[2],p0[3],p1[1]);a=max3f(a,p1[2],p1[3]);
  #pragma unroll
  for(int r=4;r<16;r+=4){a=max3f(a,p0[r],p0[r+1]);b=max3f(b,p0[r+2],p0[r+3]);a=max3f(a,p1[r],p1[r+1]);b=max3f(b,p1[r+2],p1[r+3]);}
  const float m=max2f(a,b);
  auto rr=__builtin_amdgcn_permlane32_swap(__float_as_uint(m),__float_as_uint(m),false,false);
  return max2f(__uint_as_float(rr[0]),__uint_as_float(rr[1]));
}
__device__ __forceinline__ void pv(f32x16*o,int vb,bf16x8 pa0,bf16x8 pa1,bf16x8 pa2,bf16x8 pa3){
  #pragma unroll
  for(int d0=0;d0<2;++d0){s16x4 lo[4],hi[4];
    #pragma unroll
    for(int ks=0;ks<4;++ks){
      asm volatile("ds_read_b64_tr_b16 %0,%1 offset:%c2":"=&v"(lo[ks]):"v"(vb),"i"(d0*4096+ks*1024):"memory");
      asm volatile("ds_read_b64_tr_b16 %0,%1 offset:%c2":"=&v"(hi[ks]):"v"(vb),"i"(d0*4096+ks*1024+512):"memory");}
    asm volatile("s_waitcnt lgkmcnt(0)":::"memory");SBAR();
    #define PK(k) (bf16x8){lo[k][0],lo[k][1],lo[k][2],lo[k][3],hi[k][0],hi[k][1],hi[k][2],hi[k][3]}
    o[d0]=__builtin_amdgcn_mfma_f32_32x32x16_bf16(pa0,PK(0),o[d0],0,0,0);
    o[d0]=__builtin_amdgcn_mfma_f32_32x32x16_bf16(pa1,PK(1),o[d0],0,0,0);
    o[d0]=__builtin_amdgcn_mfma_f32_32x32x16_bf16(pa2,PK(2),o[d0],0,0,0);
    o[d0]=__builtin_amdgcn_mfma_f32_32x32x16_bf16(pa3,PK(3),o[d0],0,0,0);
    #undef PK
  }
}

template<int THRL> __device__ __forceinline__ void moba_unit(int b,int h,int qb,int kkeep,const bf16*Q,const bf16*__restrict__ K,const bf16*__restrict__ V,bf16*O,const float*kmean,char*shm){
  int tid_=threadIdx.x; asm volatile("":"+v"(tid_));
  const int tid=tid_,lane=tid&63,r32=lane&31,hi=lane>>5; const int wid=__builtin_amdgcn_readfirstlane(tid>>6);
  const long rowbase=(long)b*SEQ; const int q0=qb*QB;
  const bf16*Qw=Q+(rowbase+q0+wid*QBLK)*DM+h*D;
  const bf16*Kh=K+rowbase*DM+h*D,*Vh=V+rowbase*DM+h*D;
  const unsigned lds0=(unsigned)(uintptr_t)shm;
  float*wsf=(float*)(shm+LDS_WS)+wid*64;
  { float*kmd=(float*)(shm+LDS_KM); const float*kms=kmean+(size_t)((b*NHEAD+h)*16)*64; kmd[tid]=kms[tid]; kmd[tid+512]=kms[tid+512]; }
  const bf16*ksrc=Kh+(long)lane*DM+wid*8;
  const bf16*vsrc=Vh+(long)(16*(wid&3)+(lane>>2))*DM+(wid>>2)*32+(lane&3)*8;
  const unsigned kdst=lds0+LDS_K+wid*1024, vdst=lds0+LDS_V+wid*1024;
  #define DMA_K(t,slot) glds16(ksrc+(long)(t)*KVBLK*DM,(unsigned)__builtin_amdgcn_readfirstlane(kdst+(slot)))
  #define DMA_V(t,slot) glds16(vsrc+(long)(t)*KVBLK*DM,(unsigned)__builtin_amdgcn_readfirstlane(vdst+(slot)))
  const int vb0=(int)(lds0+LDS_V)+((lane>>4)&1)*32+(lane&3)*8+(4*hi+((lane&15)>>2))*64;
  const char*Kbase=shm+LDS_K; bf16x8 kf[8];
  const lds_cptr shm3=(lds_cptr)shm; const lds_cptr kp0=shm3+LDS_K+hi*1024+r32*16; const lds_cptr vp0=shm3+LDS_V+((lane>>4)&1)*32+(lane&3)*8+(4*hi+((lane&15)>>2))*64;
  const int NT=(q0+QB)/KVBLK;
  const int t0=4*((qb>kkeep)?(qb-kkeep):0);
  DMA_K(t0,0);DMA_V(t0,0);DMA_K(t0+1,SLOTB);
  bf16x8 qr[4];
  #pragma unroll
  for(int d0=0;d0<4;++d0)qr[d0]=*reinterpret_cast<const bf16x8*>(&Qw[(long)r32*DM+d0*16+hi*8]);
  float mhat=0.f,l_reg=0.f;f32x16 o[2];o[0]=f32x16{};o[1]=f32x16{};
  unsigned selmask=0u; bool selcur=true;
  bf16x8 kx0,kx1,qx;
  { const float slope2=exp2f(-0.5f*(float)(h+1))*1.4426950408889634f;
    unsigned a0,a1,a2,b0_,b1_,b2_,c0,c1,c2; split3(slope2*(float)r32,a0,a1,a2); split3(slope2*(float)(r32+32),b0_,b1_,b2_); split3(slope2*64.f,c0,c1,c2);
    const unsigned one=0x3f80u;
    u32x4 w0,w1,wq;
    if(hi==0){ w0=(u32x4){a0|(a1<<16),a2|(c0<<16),c1|(c2<<16),one|(one<<16)}; w1=(u32x4){b0_|(b1_<<16),b2_|(c0<<16),c1|(c2<<16),one|(one<<16)}; wq=(u32x4){one|(one<<16),one,0u,0u}; }
    else     { w0=(u32x4){one,0u,0u,0u}; w1=w0; wq=(u32x4){0u,0u,0u,0u}; }
    kx0=__builtin_bit_cast(bf16x8,w0); kx1=__builtin_bit_cast(bf16x8,w1); qx=__builtin_bit_cast(bf16x8,wq); }
  #define SETQX() do{ unsigned h_,m_,l_; split3(selcur?-mhat:-1e30f,h_,m_,l_); u32x4 w_=__builtin_bit_cast(u32x4,qx); if(hi==0){w_[3]=h_|(m_<<16);}else{w_[0]=l_;} qx=__builtin_bit_cast(bf16x8,w_); }while(0)
  #define SETT(t) do{ const unsigned tb_=__float_as_uint((float)(t))>>16; u32x4 w_=__builtin_bit_cast(u32x4,qx); if(hi==0){w_[1]=0x3f80u|(tb_<<16);w_[2]=tb_|(tb_<<16);} qx=__builtin_bit_cast(bf16x8,w_); }while(0)
  #define BLK(t) do{ if((((t))&3)==0){ const int blk_=(t)>>2; selcur=(blk_==qb)||(((selmask>>blk_)&1u)!=0u); SETQX(); } }while(0)
  const int qrel=wid*QBLK+r32;
  #define CMASK(P0,P1,t) do{int jb_=(t)-(NT-4); if(jb_>=0)cmask(P0,P1,jb_,qrel,hi);}while(0)
  bool resc=false;
  #define START(P0,P1) do{ const float rm=rowmax(P0,P1); resc=false; \
    { const float dl=max2f(rm,-1024.f); mhat=fadd_s(mhat,dl); \
      _Pragma("unroll") for(int r=0;r<16;++r){P0[r]=fsub_s(P0[r],dl);P1[r]=fsub_s(P1[r],dl);} \
      SETQX(); } \
    _Pragma("unroll") for(int r=0;r<16;++r)P0[r]=__builtin_amdgcn_exp2f(P0[r]); }while(0)
  #define RESC() do{ if(resc){ asm volatile("s_waitcnt lgkmcnt(0)":::"memory"); \
      _Pragma("unroll") for(int d_=0;d_<2;++d_) _Pragma("unroll") for(int r=0;r<16;++r)o[d_][r]*=wsf[crow(r,hi)]; } }while(0)
  f32x16 pA0,pA1,pB0,pB1;
  int sl_prev=0,sl_cur=0,sl_next=SLOTB;
  #define ROT() do{sl_prev=sl_cur;sl_cur=sl_next;sl_next=(sl_next==(NSLOT-1)*SLOTB)?0:sl_next+SLOTB;}while(0)
  DMA_K(t0+2,2*SLOTB);
  WAIT_BAR(3);
  if(qb>0){
    const float*kmd=(const float*)(shm+LDS_KM)+hi*8; float gate[16];
    #pragma unroll
    for(int n=0;n<16;++n){ float s=0.f;
      if(n<qb){
        #pragma unroll
        for(int d0=0;d0<4;++d0){ const float4 a=*(const float4*)(kmd+n*64+d0*16), c=*(const float4*)(kmd+n*64+d0*16+4);
          #define QF(i) __uint_as_float(((unsigned)(unsigned short)qr[d0][i])<<16)
          s+=QF(0)*a.x+QF(1)*a.y+QF(2)*a.z+QF(3)*a.w+QF(4)*c.x+QF(5)*c.y+QF(6)*c.z+QF(7)*c.w;
          #undef QF
        }
        s+=__shfl_xor(s,32); }
      gate[n]=s; }
    #pragma unroll
    for(int k=0;k<3;++k){ float best=-INFINITY; int bi=-1;
      #pragma unroll
      for(int n=0;n<16;++n){ const bool ok=(n<qb)&&!((selmask>>n)&1u)&&(gate[n]>best); if(ok){best=gate[n];bi=n;} }
      if(bi>=0)selmask|=1u<<bi; }
    selcur=((selmask>>(t0>>2))&1u)!=0u;
  }
  SETQX(); SETT(t0);
  qkt(pA0,pA1,Kbase,qr,kx0,kx1,qx,r32,hi);asm volatile("s_nop 15\n\ts_nop 7":"+v"(pA0),"+v"(pA1));CMASK(pA0,pA1,t0);
  START(pA0,pA1);
  _Pragma("unroll") for(int r=0;r<16;++r)pA1[r]=__builtin_amdgcn_exp2f(pA1[r]);
  WAIT_BAR(0);
  DMA_K(t0+3,0);DMA_V(t0+1,SLOTB);
  ROT();
  kload8(kf,kp0+sl_cur);
  WAIT_BAR(2);
  s16x4 vlo[8],vhi[8]; u32x4 pw0,pw1,pw2,pw3;
  #define PKW(P,B) cvtpk_s(P[B],P[B+1])
  #define PAF(k) __builtin_bit_cast(bf16x8,pw##k)
  #define VFR(i) (bf16x8){vlo[i][0],vlo[i][1],vlo[i][2],vlo[i][3],vhi[i][0],vhi[i][1],vhi[i][2],vhi[i][3]}
  #define PIN(x) asm volatile("":"+v"(x))
  #define MX3(a,b,c) __builtin_fmaxf(__builtin_fmaxf((a),(b)),(c))
  #define GAPA(MF,A0,A1,A2,A3,W0,W1,PW) do{ MF; sacc+=A0; sacc+=A1; sacc+=A2; sacc+=A3; PIN(sacc); W0; W1; PIN(PW); SBAR(); }while(0)
  #define EX(v) __builtin_amdgcn_exp2f(v)
  #define GAPB(MF,X,B) do{ MF; X[B]=EX(X[B]); X[B+1]=EX(X[B+1]); X[B+2]=EX(X[B+2]); X[B+3]=EX(X[B+3]); PIN(X); SBAR(); }while(0)
  #define VRD(i) do{ vlo[i]=vtr(vp_+(((i)>>2)*4096+((i)&3)*1024)); vhi[i]=vtr(vp_+(((i)>>2)*4096+((i)&3)*1024+512)); }while(0)
  #define KRD(G,j) do{ if(G){ kload2(kf,kp0+sl_next,j); SBAR(); } }while(0)
  #define STEP(C0,C1,P0,P1,t,GK,GV,GL) do{ SBAR(); \
    const lds_cptr vp_=vp0+sl_prev; \
    VRD(0); SBAR(); float sacc=(P0[0]+P0[1]); \
    GAPA(C0=__builtin_amdgcn_mfma_f32_32x32x16_bf16(kf[0],qr[0],f32x16{},0,0,0), P0[2],P0[3],P0[4],P0[5],     pw0[0]=PKW(P0,0), pw0[1]=PKW(P0,2), pw0); \
    VRD(4); SBAR(); GAPA(C1=__builtin_amdgcn_mfma_f32_32x32x16_bf16(kf[1],qr[0],f32x16{},0,0,0), P0[6],P0[7],P0[8],P0[9],     pw0[2]=PKW(P0,4), pw0[3]=PKW(P0,6), pw0); \
    VRD(1); SBAR(); GAPA(C0=__builtin_amdgcn_mfma_f32_32x32x16_bf16(kf[2],qr[1],C0,0,0,0),   P0[10],P0[11],P0[12],P0[13], pw1[0]=PKW(P0,8), pw1[1]=PKW(P0,10), pw1); \
    VRD(5); SBAR(); GAPA(C1=__builtin_amdgcn_mfma_f32_32x32x16_bf16(kf[3],qr[1],C1,0,0,0),   P0[14],P0[15],P1[0],P1[1],   pw1[2]=PKW(P0,12),pw1[3]=PKW(P0,14), pw1); \
    VRD(2); SBAR(); GAPA(C0=__builtin_amdgcn_mfma_f32_32x32x16_bf16(kf[4],qr[2],C0,0,0,0),   P1[2],P1[3],P1[4],P1[5],     pw2[0]=PKW(P1,0), pw2[1]=PKW(P1,2), pw2); \
    VRD(6); SBAR(); GAPA(C1=__builtin_amdgcn_mfma_f32_32x32x16_bf16(kf[5],qr[2],C1,0,0,0),   P1[6],P1[7],P1[8],P1[9],     pw2[2]=PKW(P1,4), pw2[3]=PKW(P1,6), pw2); \
    VRD(3); SBAR(); GAPA(C0=__builtin_amdgcn_mfma_f32_32x32x16_bf16(kf[6],qr[3],C0,0,0,0),   P1[10],P1[11],P1[12],P1[13], pw3[0]=PKW(P1,8), pw3[1]=PKW(P1,10), pw3); \
    VRD(7); SBAR(); GAPA(C1=__builtin_amdgcn_mfma_f32_32x32x16_bf16(kf[7],qr[3],C1,0,0,0),   P1[14],P1[15],0.f,0.f,       pw3[2]=PKW(P1,12),pw3[3]=PKW(P1,14), pw3); \
    C0=__builtin_amdgcn_mfma_f32_32x32x16_bf16(kx0,qx,C0,0,0,0); C1=__builtin_amdgcn_mfma_f32_32x32x16_bf16(kx1,qx,C1,0,0,0); SBAR(); \
    l_reg+=sacc; \
    if(GK){DMA_K((t)+3,sl_cur);} if(GV){DMA_V((t)+1,sl_next);} \
    CMASK(C0,C1,t); \
    { float a=MX3(C0[0],C0[1],C1[0]),b=MX3(C0[2],C0[3],C1[1]); a=MX3(a,C1[2],C1[3]); \
      _Pragma("unroll") for(int r=4;r<16;r+=4){a=MX3(a,C0[r],C0[r+1]);b=MX3(b,C0[r+2],C0[r+3]);a=MX3(a,C1[r],C1[r+1]);b=MX3(b,C1[r+2],C1[r+3]);} \
      float rm=__builtin_fmaxf(a,b); { auto rr=__builtin_amdgcn_permlane32_swap(__float_as_uint(rm),__float_as_uint(rm),false,false); rm=__builtin_fmaxf(__uint_as_float(rr[0]),__uint_as_float(rr[1])); } \
      resc=false; \
      if(__builtin_expect(__any(rm>(float)THRL),0)){ const float dl=__builtin_fmaxf(rm,0.f); mhat+=dl; \
        _Pragma("unroll") for(int r=0;r<16;++r){C0[r]-=dl;C1[r]-=dl;} \
        SETQX(); \
        const float f=__builtin_amdgcn_exp2f(-dl); l_reg*=f; if(hi==0)wsf[r32]=f; resc=true; } } \
    SBAR(); \
    GAPB(o[0]=__builtin_amdgcn_mfma_f32_32x32x16_bf16(PAF(0),VFR(0),o[0],0,0,0), C0,0); \
    GAPB(o[1]=__builtin_amdgcn_mfma_f32_32x32x16_bf16(PAF(0),VFR(4),o[1],0,0,0), C0,4); \
    KRD(GL,0); GAPB(o[0]=__builtin_amdgcn_mfma_f32_32x32x16_bf16(PAF(1),VFR(1),o[0],0,0,0), C0,8); \
    KRD(GL,1); GAPB(o[1]=__builtin_amdgcn_mfma_f32_32x32x16_bf16(PAF(1),VFR(5),o[1],0,0,0), C0,12); \
    KRD(GL,2); GAPB(o[0]=__builtin_amdgcn_mfma_f32_32x32x16_bf16(PAF(2),VFR(2),o[0],0,0,0), C1,0); \
    KRD(GL,3); GAPB(o[1]=__builtin_amdgcn_mfma_f32_32x32x16_bf16(PAF(2),VFR(6),o[1],0,0,0), C1,4); \
    GAPB(o[0]=__builtin_amdgcn_mfma_f32_32x32x16_bf16(PAF(3),VFR(3),o[0],0,0,0), C1,8); \
    GAPB(o[1]=__builtin_amdgcn_mfma_f32_32x32x16_bf16(PAF(3),VFR(7),o[1],0,0,0), C1,12); \
    }while(0)
  int t=t0+1;
  #undef CMASK
  #define CMASK(P0,P1,t) do{}while(0)
  for(;t+5<NT;t+=2){
    SETT(t);   STEP(pB0,pB1,pA0,pA1,t,true,true,true);     WAIT_BAR(2); RESC(); ROT();
    BLK(t+1); SETT(t+1); STEP(pA0,pA1,pB0,pB1,t+1,true,true,true);   WAIT_BAR(2); RESC(); ROT();
  }
  #undef CMASK
  #define CMASK(P0,P1,t) do{int jb_=(t)-(NT-4); if(jb_>=0)cmask(P0,P1,jb_,qrel,hi);}while(0)
  #define ENDW(tt) do{ if((tt)+3<NT){WAIT_BAR(2);} else if((tt)+2<NT){WAIT_BAR(1);} else {WAIT_BAR(0);} }while(0)
  for(;t+1<NT;t+=2){
    SETT(t);   STEP(pB0,pB1,pA0,pA1,t,(t+3<NT),(t+1<NT),(t+1<NT));       ENDW(t);   RESC(); ROT();
    BLK(t+1); SETT(t+1); STEP(pA0,pA1,pB0,pB1,t+1,(t+4<NT),(t+2<NT),(t+2<NT));     ENDW(t+1); RESC(); ROT();
  }
  SETT(NT-1); STEP(pB0,pB1,pA0,pA1,NT-1,false,false,false); RESC();
  { float sacc=pB0[0]+pB0[1]; _Pragma("unroll") for(int r=2;r<16;++r)sacc+=pB0[r]; _Pragma("unroll") for(int r=0;r<16;++r)sacc+=pB1[r]; l_reg+=sacc;
    pw0=(u32x4){PKW(pB0,0),PKW(pB0,2),PKW(pB0,4),PKW(pB0,6)};pw1=(u32x4){PKW(pB0,8),PKW(pB0,10),PKW(pB0,12),PKW(pB0,14)};pw2=(u32x4){PKW(pB1,0),PKW(pB1,2),PKW(pB1,4),PKW(pB1,6)};pw3=(u32x4){PKW(pB1,8),PKW(pB1,10),PKW(pB1,12),PKW(pB1,14)};
    SBAR(); pv(o,vb0+sl_cur,PAF(0),PAF(1),PAF(2),PAF(3)); }
  #undef PKW
  #undef PAF
  #undef VFR
  #undef PIN
  #undef MX3
  #undef GAPA
  #undef GAPB
  #undef EX
  #undef VRD
  #undef KRD
  #undef STEP
  #undef ENDW
  #undef SETQX
  #undef SETT
  #undef BLK
  {auto rr=__builtin_amdgcn_permlane32_swap(__float_as_uint(l_reg),__float_as_uint(l_reg),false,false);l_reg=__uint_as_float(rr[0])+__uint_as_float(rr[1]);}
  if(hi==0)wsf[32+r32]=l_reg;asm volatile("s_waitcnt lgkmcnt(0)":::"memory");
  float rli[16];
  #pragma unroll
  for(int r=0;r<16;++r)rli[r]=__builtin_amdgcn_rcpf(wsf[32+crow(r,hi)]);
  bf16*Ow=O+(rowbase+q0+wid*QBLK)*DM+h*D;
  { bf16*stg=(bf16*)(shm+LDS_OST)+wid*2048;
    #pragma unroll
    for(int r=0;r<16;++r){const int orow=crow(r,hi);
      #pragma unroll
      for(int d0=0;d0<2;++d0)stg[orow*64+d0*32+r32]=__float2bfloat16(o[d0][r]*rli[r]);}
    asm volatile("s_waitcnt lgkmcnt(0)":::"memory");
    #pragma unroll
    for(int i=0;i<4;++i){const int row=i*8+(lane>>3),ch=lane&7; const u32x4 v=*(const u32x4*)(stg+row*64+ch*8); *(u32x4*)(Ow+(long)row*DM+ch*8)=v;} }
  asm volatile("s_waitcnt lgkmcnt(0)\n\ts_barrier":::"memory");
  #undef DMA_K
  #undef DMA_V
  #undef CMASK
  #undef START
  #undef RESC
  #undef ROT
}
constexpr int MOBA_LDS_BYTES=LDS_BYTES;

constexpr int SW_LDS_K=0, SW_LDS_V=4*SLOTB, SW_LDS_WS=8*SLOTB, SW_LDS_OST=SW_LDS_WS+NW*256, SW_LDS_BYTES=SW_LDS_OST+NW*4096;
__device__ __forceinline__ void swa_unit(int b,int nb,int kvh,bf16*QO,const bf16*__restrict__ KV,const float*sinks,char*shm){
  int tid_=threadIdx.x; asm volatile("":"+v"(tid_));
  const int tid=tid_,lane=tid&63,r32=lane&31,hi=lane>>5; const int wid=__builtin_amdgcn_readfirstlane(tid>>6);
  const int hq=kvh*8+wid; const long rowbase=(long)b*SEQ; const int q0=nb*128;
  const unsigned lds0=(unsigned)(uintptr_t)shm;
  float*wsf=(float*)(shm+SW_LDS_WS)+wid*64;
  const int c0=(nb==0)?2:0;
  for(int c=c0;c<4;++c){
    const long kp=rowbase+q0-128+64*c;
    glds16(KV+(kp+lane)*DM+kvh*64+wid*8,(unsigned)__builtin_amdgcn_readfirstlane(lds0+SW_LDS_K+c*SLOTB+wid*1024));
    glds16(KV+(kp+16*(wid&3)+(lane>>2))*DM+128+kvh*64+(wid>>2)*32+(lane&3)*8,(unsigned)__builtin_amdgcn_readfirstlane(lds0+SW_LDS_V+c*SLOTB+wid*1024)); }
  bf16x8 qr[4][4];
  #pragma unroll
  for(int i=0;i<4;++i)
    #pragma unroll
    for(int d0=0;d0<4;++d0)qr[i][d0]=*reinterpret_cast<const bf16x8*>(&QO[(rowbase+q0+32*i+r32)*DM+hq*64+d0*16+hi*8]);
  const float slope2=exp2f(-0.5f*(float)(hq+1))*1.4426950408889634f;
  const float sink2=sinks[hq]*1.4426950408889634f;
  bf16x8 kx0,kx1,qx;
  { unsigned a0,a1,a2,b0_,b1_,b2_,c0_,c1_,c2_; split3(slope2*(float)r32,a0,a1,a2); split3(slope2*(float)(r32+32),b0_,b1_,b2_); split3(slope2*64.f,c0_,c1_,c2_);
    const unsigned one=0x3f80u; u32x4 w0,w1,wq;
    if(hi==0){ w0=(u32x4){a0|(a1<<16),a2|(c0_<<16),c1_|(c2_<<16),one|(one<<16)}; w1=(u32x4){b0_|(b1_<<16),b2_|(c0_<<16),c1_|(c2_<<16),one|(one<<16)}; wq=(u32x4){one|(one<<16),one,0u,0u}; }
    else     { w0=(u32x4){one,0u,0u,0u}; w1=w0; wq=(u32x4){0u,0u,0u,0u}; }
    kx0=__builtin_bit_cast(bf16x8,w0); kx1=__builtin_bit_cast(bf16x8,w1); qx=__builtin_bit_cast(bf16x8,wq); }
  const int vb0=(int)(lds0+SW_LDS_V)+((lane>>4)&1)*32+(lane&3)*8+(4*hi+((lane&15)>>2))*64;
  asm volatile("s_waitcnt vmcnt(0) lgkmcnt(0)\n\ts_barrier":::"memory");
  #pragma unroll
  for(int i=0;i<4;++i){
    const int qi=32*i+r32;
    int cbeg=(i<2)?0:1; const int cend=cbeg+3; if(cbeg<c0)cbeg=c0;
    float mhat=0.f,l_reg=0.f; f32x16 o[2]; o[0]=f32x16{}; o[1]=f32x16{};
    { unsigned h_,m_,l_; split3(0.f,h_,m_,l_); u32x4 w_=__builtin_bit_cast(u32x4,qx); if(hi==0){w_[3]=h_|(m_<<16);}else{w_[0]=l_;} qx=__builtin_bit_cast(bf16x8,w_); }
    for(int c=cbeg;c<cend;++c){
      { const unsigned tb_=__float_as_uint((float)c)>>16; u32x4 w_=__builtin_bit_cast(u32x4,qx); if(hi==0){w_[1]=0x3f80u|(tb_<<16);w_[2]=tb_|(tb_<<16);} qx=__builtin_bit_cast(bf16x8,w_); }
      f32x16 p0,p1; qkt(p0,p1,shm+SW_LDS_K+c*SLOTB,qr[i],kx0,kx1,qx,r32,hi);
      { const int lo_=qi+1-64*c, hi_=qi+128-64*c;
        #pragma unroll
        for(int r=0;r<16;++r){ const int kv=crow(r,hi); if(kv<lo_||kv>hi_)p0[r]=-INFINITY; if(kv+32<lo_||kv+32>hi_)p1[r]=-INFINITY; } }
      const float rm=rowmax(p0,p1); const bool first=(c==cbeg);
      if(first||__any(rm>100.f)){
        const float dl=first?fmaxf(rm,-1024.f):fmaxf(rm,0.f); mhat+=dl;
        #pragma unroll
        for(int r=0;r<16;++r){p0[r]-=dl;p1[r]-=dl;}
        if(!first){ const float f=__builtin_amdgcn_exp2f(-dl); l_reg*=f; if(hi==0)wsf[r32]=f; asm volatile("s_waitcnt lgkmcnt(0)":::"memory");
          #pragma unroll
          for(int d_=0;d_<2;++d_)
            #pragma unroll
            for(int r=0;r<16;++r)o[d_][r]*=wsf[crow(r,hi)]; }
        { unsigned h_,m_,l_; split3(-mhat,h_,m_,l_); u32x4 w_=__builtin_bit_cast(u32x4,qx); if(hi==0){w_[3]=h_|(m_<<16);}else{w_[0]=l_;} qx=__builtin_bit_cast(bf16x8,w_); }
      }
      float sacc=0.f;
      #pragma unroll
      for(int r=0;r<16;++r){p0[r]=__builtin_amdgcn_exp2f(p0[r]);p1[r]=__builtin_amdgcn_exp2f(p1[r]);sacc+=p0[r]+p1[r];}
      l_reg+=sacc;
      const u32x4 pw0={cvtpk_s(p0[0],p0[1]),cvtpk_s(p0[2],p0[3]),cvtpk_s(p0[4],p0[5]),cvtpk_s(p0[6],p0[7])},pw1={cvtpk_s(p0[8],p0[9]),cvtpk_s(p0[10],p0[11]),cvtpk_s(p0[12],p0[13]),cvtpk_s(p0[14],p0[15])};
      const u32x4 pw2={cvtpk_s(p1[0],p1[1]),cvtpk_s(p1[2],p1[3]),cvtpk_s(p1[4],p1[5]),cvtpk_s(p1[6],p1[7])},pw3={cvtpk_s(p1[8],p1[9]),cvtpk_s(p1[10],p1[11]),cvtpk_s(p1[12],p1[13]),cvtpk_s(p1[14],p1[15])};
      pv(o,vb0+c*SLOTB,__builtin_bit_cast(bf16x8,pw0),__builtin_bit_cast(bf16x8,pw1),__builtin_bit_cast(bf16x8,pw2),__builtin_bit_cast(bf16x8,pw3));
    }
    {auto rr=__builtin_amdgcn_permlane32_swap(__float_as_uint(l_reg),__float_as_uint(l_reg),false,false);l_reg=__uint_as_float(rr[0])+__uint_as_float(rr[1]);}
    l_reg+=__builtin_amdgcn_exp2f(sink2+slope2*(float)(128+qi)-mhat);
    if(hi==0)wsf[32+r32]=l_reg;asm volatile("s_waitcnt lgkmcnt(0)":::"memory");
    float rli[16];
    #pragma unroll
    for(int r=0;r<16;++r)rli[r]=__builtin_amdgcn_rcpf(wsf[32+crow(r,hi)]);
    bf16*Ow=QO+(rowbase+q0+32*i)*DM+hq*64;
    { bf16*stg=(bf16*)(shm+SW_LDS_OST)+wid*2048;
      #pragma unroll
      for(int r=0;r<16;++r){const int orow=crow(r,hi);
        #pragma unroll
        for(int d0=0;d0<2;++d0)stg[orow*64+d0*32+r32]=__float2bfloat16(o[d0][r]*rli[r]);}
      asm volatile("s_waitcnt lgkmcnt(0)":::"memory");
      #pragma unroll
      for(int j=0;j<4;++j){const int row=j*8+(lane>>3),ch=lane&7; const u32x4 v=*(const u32x4*)(stg+row*64+ch*8); *(u32x4*)(Ow+(long)row*DM+ch*8)=v;}
      asm volatile("s_waitcnt lgkmcnt(0)":::"memory"); }
  }
  asm volatile("s_waitcnt lgkmcnt(0)\n\ts_barrier":::"memory");
}
#undef SBAR
#undef WAIT_BAR
}

__device__ const int MOBA_KH[16] = {1, 2, 2, 3, 4, 5, 7, 9, 13, 15, 15, 15, 15, 15, 15, 15};
constexpr int MOBA_ML = 8;
__device__ const unsigned char MOBA_TAB[32][MOBA_ML] = {
  {255,126,246,150,63,178,31,208},
  {239,125,230,134,62,162,30,192},
  {223,124,214,118,61,146,29,176},
  {207,123,198,102,60,130,28,160},
  {191,122,182,245,116,114,27,144},
  {175,121,166,229,100,98,26,128},
  {159,248,200,228,84,82,25,112},
  {254,217,184,212,79,66,24,96},
  {238,201,168,196,78,50,23,80},
  {222,185,152,180,77,47,22,64},
  {206,169,136,164,76,46,21,48},
  {190,153,120,148,75,45,20,32},
  {174,137,247,213,74,44,19,16},
  {158,127,231,197,73,43,18,0},
  {253,250,215,181,72,42,241,17},
  {237,234,199,165,71,41,225,15},
  {221,218,183,149,70,40,209,14},
  {205,202,167,133,69,39,193,13},
  {189,186,151,117,68,38,177,12},
  {173,170,135,101,243,59,161,11},
  {157,154,119,95,227,58,145,10},
  {143,138,111,94,211,57,129,9},
  {142,249,232,93,195,56,113,8},
  {141,233,216,92,179,55,97,7},
  {252,251,110,91,163,54,81,6},
  {236,235,109,90,147,53,65,5},
  {220,219,108,89,131,52,49,4},
  {204,203,107,88,115,51,33,3},
  {188,187,106,87,99,242,37,2},
  {172,171,105,86,83,226,36,1},
  {156,155,104,85,67,210,35,240},
  {140,139,103,244,132,194,34,224}};
constexpr int N_PHASES = 17;
#ifndef MK_ONE_LAUNCH
#define MK_ONE_LAUNCH 1
#endif
__global__ void __launch_bounds__(NWAVES * 64, 2) fwd_kernel(Args args) {
    extern __shared__ __attribute__((aligned(16))) unsigned char lds[];
    Frame F;
    F.lds = (LAS unsigned char*)lds;
    F.MISC = (volatile LAS unsigned*)(F.lds + MISC_OFF);
    F.tid = threadIdx.x; F.lane = F.tid & 63; F.wave = __builtin_amdgcn_readfirstlane(F.tid >> 6);
    F.G = gridDim.x; F.ws = args.ws; F.ctl = (gu32*)(args.ws + WS_CTL);
#define ws (args.ws)
    const int lo = args.ph_lo, hi = args.ph_hi;
    if (F.tid < 16) F.MISC[F.tid] = 0u;
    __syncthreads();
    XcdBarrier bar; bar.bar = (unsigned*)(F.ctl + CW_BAR); bar.x = 0; bar.st = nullptr;
    if (MK_ONE_LAUNCH) bar = xcd_barrier_post((unsigned*)(F.ctl + CW_BAR), F.MISC + MW_BAR);
#define IN(k) (lo <= (k) && (k) < hi)
#define GRID_BAR() do { if (MK_ONE_LAUNCH) xcd_barrier(bar); } while (0)
    const int gw = blockIdx.x * NWAVES + F.wave, NGW = F.G * NWAVES;

#define x_in (args.in[0])
#define w_qkv_a (args.in[1])
#define w_o_a (args.in[2])
#define w_kv_sh (args.in[3])
#define w_q_b (args.in[4])
#define w_o_b (args.in[5])
#define sinks_b (args.in[6])
#define w_gate_d (args.in[7])
#define w_up_d (args.in[8])
#define w_down_d (args.in[9])
#define w_router (args.in[10])
#define w_gate_e (args.in[11])
#define w_up_e (args.in[12])
#define w_down_e (args.in[13])
#define ln_gain (args.in[14])
#define ln_bias (args.in[15])
    float* const out = args.out;
#define Wqkv_t ((bf16*)(ws + WS_WQKV))
#define Woa_t ((bf16*)(ws + WS_WOA))
#define Wgud_t ((bf16*)(ws + WS_WGUD))
#define Wdd_t ((bf16*)(ws + WS_WDD))
#define Wqb_t ((bf16*)(ws + WS_WQB))
#define Wob_t ((bf16*)(ws + WS_WOB))
#define Wgue8 ((unsigned char*)(ws + WS_WGUE))
#define Wde8 ((unsigned char*)(ws + WS_WDE))
#define X8 ((unsigned char*)(ws + WS_X8))
#define H8 ((unsigned char*)(ws + WS_H))
#define XB ((bf16*)(ws + WS_XB))
#define QB ((bf16*)(ws + WS_Q))
#define KB ((bf16*)(ws + WS_K))
#define VB ((bf16*)(ws + WS_V))
#define HB ((bf16*)(ws + WS_H))
#define kmean ((float*)(ws + WS_KMEAN))
#define rowtok ((int*)(ws + R_ROWTOK))
#define rowpair ((int*)(ws + R_ROWPAIR))
#define roww ((float*)(ws + R_ROWW))
#define re ((int*)(ws + R_RE))
#define rwf ((float*)(ws + R_RWF))
#define cntg ((int*)(ws + R_CNT))
#define pairpos ((int*)(ws + R_PPOS))
#define PARTB ((float*)(ws + WS_PART))
#define YP ((bf16*)out)
#define X1H ((bf16*)out)
#define X2H ((bf16*)out + (size_t)T * D)
#define X3H XB

    if (IN(0)) {
        LAS float* scr = (LAS float*)(F.lds + F.wave * 16384);
        constexpr int I_QKV = 16 * 96, I_SQ = 16 * 32, I_GD = 16 * 88, I_DD = 44 * 32, I_KV = 16 * 8, I_GE = 16 * 112, I_DE = 56 * 32;
        constexpr int NITEMS = I_QKV + I_SQ + 2 * I_GD + I_DD + I_SQ + I_KV + I_SQ;
        for (int it = gw; it < NITEMS; it += NGW) {
            int r = it;
            if (r < I_QKV) { tr_job(w_qkv_a, D, 3 * D, Wqkv_t, D, 0, 0, scr, r, F.lane); continue; } r -= I_QKV;
            if (r < I_SQ) { tr_job(w_o_a, D, D, Woa_t, D, 0, 0, scr, r, F.lane); continue; } r -= I_SQ;
            if (r < I_GD) { tr_job8<true>(w_gate_d, D, FFD, (unsigned char*)Wgud_t, D, 1, WSC_GU, scr, r, F.lane); continue; } r -= I_GD;
            if (r < I_GD) { tr_job8<true>(w_up_d, D, FFD, (unsigned char*)Wgud_t, D, 2, WSC_GU, scr, r, F.lane); continue; } r -= I_GD;
            if (r < I_DD) { tr_job8<false>(w_down_d, FFD, D, (unsigned char*)Wdd_t, FFD, 0, WSC_D, scr, r, F.lane); continue; } r -= I_DD;
            if (r < I_SQ) { tr_job<true>(w_q_b, D, D, Wqb_t, D, 0, 0, scr, r, F.lane); continue; } r -= I_SQ;
            if (r < I_KV) { tr_job<true>(w_kv_sh, D, 256, Wqb_t, D, 0, D, scr, r, F.lane); continue; } r -= I_KV;
            tr_job(w_o_b, D, D, Wob_t, D, 0, 0, scr, r, F.lane);
        }
        for (int i = gw * 64 + F.lane; i < BATCH * NH * NBLK * HD; i += NGW * 64) kmean[i] = 0.f;
        for (size_t i = (size_t)gw * 64 + F.lane; i < (size_t)T * D / 8; i += (size_t)NGW * 64) {
            const f32x4 a = *(const f32x4*)(x_in + i * 8), c = *(const f32x4*)(x_in + i * 8 + 4);
            v4u o; o.x = pk2(a.x, a.y); o.y = pk2(a.z, a.w); o.z = pk2(c.x, c.y); o.w = pk2(c.z, c.w); *(v4u*)(XB + i * 8) = o; }
        GRID_BAR();
    }
    if (IN(1)) {
        pg8::Gemm g{XB, Wqkv_t, D, D, D}; pg8::StaticOrder S; S.init(T / 256, 3 * D / 256, F.G, (int)blockIdx.x);
        pg8::EpiBf16 E{QB, D, D, (size_t)(WS_K - WS_Q) / 2, C2, kmean};
        pg8::gemm_phase<pg8::EpiBf16, pg8::StaticOrder, true, false>(F.lds, g, S, E);
        GRID_BAR();
    }
    constexpr int MW_GE = 16 * 112, MW_DE = 56 * 32, NMOEW = 16 * MW_GE + 8 * MW_DE;
#define MOE_WITEM(ridx) do { int r = (ridx); LAS float* scr = (LAS float*)(F.lds + F.wave * 16384); \
        if (r < 16 * MW_GE) { const int j = r / MW_GE, e = j >> 1, up = j & 1; r -= j * MW_GE; \
            tr_job8<true>((up ? w_up_e : w_gate_e) + (size_t)e * D * FFE, D, FFE, Wgue8 + (size_t)e * 2 * FFE * D, D, 1 + up, WSC_GU, scr, r, F.lane); } \
        else { r -= 16 * MW_GE; const int e = r / MW_DE; r -= e * MW_DE; \
            tr_job8<false>(w_down_e + (size_t)e * FFE * D, FFE, D, Wde8 + (size_t)e * D * FFE, FFE, 0, WSC_D, scr, r, F.lane); } } while (0)
    if (IN(3)) {
        if (F.G == 256) { const int x = blockIdx.x & 7, l = blockIdx.x >> 3;
            for (int j = 0; j < MOBA_ML; ++j) { const int code = MOBA_TAB[l][j], h = code >> 4, qbt = code & 15;
                mattn::moba_unit<100>(x, h, qbt, MOBA_KH[h], (const mattn::bf16*)QB, (const mattn::bf16*)KB, (const mattn::bf16*)VB, (mattn::bf16*)XB, kmean, (char*)lds);
                for (int rr = j; rr * NGW + gw < NMOEW; rr += MOBA_ML) MOE_WITEM(rr * NGW + gw);
                VM_WAIT(); __syncthreads(); } }
        else { for (int u = blockIdx.x; u < BATCH * NH * NBLK; u += F.G) { const int bh = u >> 4, h = bh % NH;
                mattn::moba_unit<100>(bh / NH, h, u & 15, MOBA_KH[h], (const mattn::bf16*)QB, (const mattn::bf16*)KB, (const mattn::bf16*)VB, (mattn::bf16*)XB, kmean, (char*)lds); }
            for (int i = gw; i < NMOEW; i += NGW) MOE_WITEM(i); }
        GRID_BAR();
    }
    if (IN(4)) {
        pg8::Gemm g{XB, Woa_t, D, D, D}; pg8::StaticOrder S; S.init(T / 256, D / 256, F.G, (int)blockIdx.x);
        pg8::EpiBf16 E{QB, D, 0, 0, 1.f, nullptr};
        pg8::gemm_phase<pg8::EpiBf16, pg8::StaticOrder, true, false>(F.lds, g, S, E);
        GRID_BAR();
    }
#define LN_LOAD(XH16, XIN, MIX, m_, xv_, mv_) do { _Pragma("unroll") for (int j = 0; j < 4; ++j) { \
        if (XH16) { const unsigned long long t_ = *(const unsigned long long*)((const bf16*)(XIN) + (size_t)(m_) * D + 256 * j + 4 * F.lane); xv_[j] = (f32x4){hlo((unsigned)t_), hhi((unsigned)t_), hlo((unsigned)(t_ >> 32)), hhi((unsigned)(t_ >> 32))}; } \
        else xv_[j] = *(const f32x4*)((const float*)(XIN) + (size_t)(m_) * D + 256 * j + 4 * F.lane); \
        mv_[j] = *(const unsigned long long*)((MIX) + (size_t)(m_) * D + 256 * j + 4 * F.lane); } } while (0)
#define LN_MIX(v, xv, mv) do { _Pragma("unroll") for (int j = 0; j < 4; ++j) v[j] = (f32x4){ALPHA * xv[j].x + bflo((unsigned)mv[j]), ALPHA * xv[j].y + bfhi((unsigned)mv[j]), ALPHA * xv[j].z + bflo((unsigned)(mv[j] >> 32)), ALPHA * xv[j].w + bfhi((unsigned)(mv[j] >> 32))}; } while (0)
#define LN_STORE_H(XOUT, m_, v) do { _Pragma("unroll") for (int j = 0; j < 4; ++j) *(unsigned long long*)((XOUT) + (size_t)(m_) * D + 256 * j + 4 * F.lane) = (unsigned long long)pkh2(v[j].x, v[j].y) | ((unsigned long long)pkh2(v[j].z, v[j].w) << 32); } while (0)
#define LN_STORE_Q8(m_, v) do { _Pragma("unroll") for (int j = 0; j < 4; ++j) *(unsigned*)(X8 + (size_t)(m_) * D + 256 * j + 4 * F.lane) = pg8::pk4_i8(v[j].x * XSC, v[j].y * XSC, v[j].z * XSC, v[j].w * XSC); } while (0)
#define LN_PHASE(li, XH16, XIN, MIX, XOUT, Q8OUT) do { LnPar P; ln_load_par(P, ln_gain + (li) * D, ln_bias + (li) * D, F.lane); \
        f32x4 xv[4], xn[4]; unsigned long long mv[4], mn[4]; \
        if (gw < T) LN_LOAD(XH16, XIN, MIX, gw, xv, mv); \
        for (int m = gw; m < T; m += NGW) { f32x4 v[4]; \
            if (m + NGW < T) LN_LOAD(XH16, XIN, MIX, m + NGW, xn, mn);             \
            LN_MIX(v, xv, mv); ln_row(v, P); LN_STORE_H(XOUT, m, v); if (Q8OUT) LN_STORE_Q8(m, v); \
            _Pragma("unroll") for (int j = 0; j < 4; ++j) { xv[j] = xn[j]; mv[j] = mn[j]; } } } while (0)
    if (IN(5)) { LN_PHASE(0, false, x_in, QB, X1H, true); GRID_BAR(); }
    if (IN(6)) {
        pg8::Gemm g{(const pg8::bf16_t*)X8, Wgud_t, D, D, D}; pg8::StaticOrder S; S.init(T / 256, 2 * FFD / 256, F.G, (int)blockIdx.x);
        pg8::EpiSwigluF8<true> E{H8, FFD, 1.f / (XSC * WSC_GU), HSC};
        pg8::gemm_phase<pg8::EpiSwigluF8<true>, pg8::StaticOrder, true, false, 2>(F.lds, g, S, E);
        GRID_BAR();
    }
    if (IN(7)) {
        pg8::Gemm g{(const pg8::bf16_t*)H8, Wdd_t, FFD, FFD, FFD}; pg8::StaticOrder S; S.init(T / 256, D / 256, F.G, (int)blockIdx.x);
        pg8::EpiBf16 E{XB, D, 0, 0, 1.f / (HSC * WSC_D), nullptr};
        pg8::gemm_phase<pg8::EpiBf16, pg8::StaticOrder, true, false, 1>(F.lds, g, S, E);
        GRID_BAR();
    }
    if (IN(8)) { LN_PHASE(1, true, X1H, XB, X2H, false); GRID_BAR(); }
    if (IN(9)) {
        pg8::Gemm g{X2H, Wqb_t, D, D, D}; pg8::StaticOrder S; S.init(T / 256, 1280 / 256, F.G, (int)blockIdx.x);
        pg8::EpiBf16 E{QB, D, D, (size_t)(WS_K - WS_Q) / 2, C2, nullptr};
        pg8::gemm_phase<pg8::EpiBf16, pg8::StaticOrder, true, false, 3>(F.lds, g, S, E);
        GRID_BAR();
    }
    if (IN(10)) {
        for (int u = blockIdx.x; u < BATCH * (SEQ / SW) * 2; u += F.G) { const int b = u >> 6, nb = (u & 63) >> 1, kvh = u & 1; mattn::swa_unit(b, nb, kvh, (mattn::bf16*)QB, (const mattn::bf16*)KB, sinks_b, (char*)lds); }
        GRID_BAR();
    }
    if (IN(11)) {
        pg8::Gemm g{QB, Wob_t, D, D, D}; pg8::StaticOrder S; S.init(T / 256, D / 256, F.G, (int)blockIdx.x);
        pg8::EpiBf16 E{KB, D, 0, 0, 1.f, nullptr};
        pg8::gemm_phase<pg8::EpiBf16, pg8::StaticOrder, true, false>(F.lds, g, S, E);
        GRID_BAR();
    }
    if (IN(12)) {
        LnPar P; ln_load_par(P, ln_gain + 2 * D, ln_bias + 2 * D, F.lane);
        LAS int* sre = (LAS int*)(F.lds);
        for (int c = blockIdx.x; c < T / 128; c += F.G) {
            __syncthreads();
            f32x4 xv[4], xn[4]; unsigned long long mv[4], mn[4];
            LN_LOAD(true, X2H, KB, c * 128 + F.wave * 16, xv, mv);
            for (int j16 = 0; j16 < 16; ++j16) {
                const int m = c * 128 + F.wave * 16 + j16; f32x4 v[4];
                if (j16 < 15) LN_LOAD(true, X2H, KB, m + 1, xn, mn);
                LN_MIX(v, xv, mv);
#pragma unroll
                for (int j = 0; j < 4; ++j) { xv[j] = xn[j]; mv[j] = mn[j]; }
                ln_row(v, P);
                LN_STORE_H(X3H, m, v); LN_STORE_Q8(m, v);
                float lg[NE];
#pragma unroll
                for (int e = 0; e < NE; ++e) lg[e] = 0.f;
#pragma unroll
                for (int j = 0; j < 4; ++j)
#pragma unroll
                    for (int i = 0; i < 4; ++i) { const float* wr_ = w_router + (size_t)(256 * j + 4 * F.lane + i) * NE; const f32x4 wa = *(const f32x4*)wr_, wb = *(const f32x4*)(wr_ + 4); const float xv = v[j][i];
                        lg[0] += xv * wa.x; lg[1] += xv * wa.y; lg[2] += xv * wa.z; lg[3] += xv * wa.w; lg[4] += xv * wb.x; lg[5] += xv * wb.y; lg[6] += xv * wb.z; lg[7] += xv * wb.w; }
#pragma unroll
                for (int e = 0; e < NE; ++e) lg[e] = wave_sum(lg[e]);
                int e0 = 0; float v0 = lg[0];
#pragma unroll
                for (int e = 1; e < NE; ++e) if (lg[e] > v0) { v0 = lg[e]; e0 = e; }
                int e1 = -1; float v1 = -INFINITY;
#pragma unroll
                for (int e = 0; e < NE; ++e) if (e != e0 && lg[e] > v1) { v1 = lg[e]; e1 = e; }
                const float p1 = __expf(v1 - v0), w0 = 1.f / (1.f + p1), w1 = p1 * w0;
                if (F.lane == 0) { re[m] = e0 | (e1 << 8); rwf[2 * m] = w0; rwf[2 * m + 1] = w1; sre[F.wave * 16 + j16] = e0 | (e1 << 8); }
            }
            __syncthreads();
            if (F.tid < NE) { int cnt = 0; for (int i = 0; i < 128; ++i) { const int pe = sre[i]; cnt += ((pe & 255) == F.tid) + ((pe >> 8) == F.tid); } cntg[c * NE + F.tid] = cnt; }
        }
        GRID_BAR();
    }
    if (IN(13)) {
        route_tables(F, cntg);
        for (int c = blockIdx.x; c < T / 128; c += F.G) {
            __syncthreads();
            if (F.tid < NE) { unsigned s = F.MISC[MW_START + F.tid]; for (int cc = 0; cc < c; ++cc) s += F.MISC[MW_CNT + cc * NE + F.tid]; F.MISC[MW_CBASE + F.tid] = s; }
            if (F.tid < 256) { const int tok = c * 128 + (F.tid >> 1), k = F.tid & 1; F.MISC[MW_SPAIR + F.tid] = (unsigned)((re[tok] >> (8 * k)) & 255); }
            __syncthreads();
            if (F.tid < 256) { const int tok = c * 128 + (F.tid >> 1), k = F.tid & 1; const unsigned e = F.MISC[MW_SPAIR + F.tid]; unsigned rank = 0;
                for (int p = 0; p < F.tid; ++p) rank += (F.MISC[MW_SPAIR + p] == e) ? 1u : 0u;
                const unsigned pos = F.MISC[MW_CBASE + e] + rank;
                rowtok[pos] = tok; rowpair[pos] = 2 * tok + k; roww[pos] = rwf[2 * tok + k]; pairpos[2 * tok + k] = (int)pos; }
        }
        if (blockIdx.x == 0) {
            for (int e = 0; e < NE; ++e) { const unsigned a = F.MISC[MW_START + e] + F.MISC[MW_TOTAL + e], z = F.MISC[MW_START + e + 1];
                for (unsigned p = a + F.tid; p < z; p += NWAVES * 64) { rowtok[p] = 0; rowpair[p] = -1; roww[p] = 0.f; } }
        }
        GRID_BAR();
    }
    if (IN(14)) {
        if (!MK_ONE_LAUNCH) route_tables(F, cntg);
        const int ntl = (int)F.MISC[MW_NTILES];
        pg8::Gemm g{(const pg8::bf16_t*)X8, (const pg8::bf16_t*)Wgue8, D, D, D};
        pg8::MoeOrder S; S.so.init(ntl, FFE / 128, F.G, (int)blockIdx.x); S.texp = (const LAS int*)(F.MISC + MW_TEXP); S.estride = (size_t)2 * FFE * D; S.rows = rowtok;
        pg8::EpiSwigluF8<true> E{H8, FFE, 1.f / (XSC * WSC_GU), HSC};
        pg8::gemm_phase<pg8::EpiSwigluF8<true>, pg8::MoeOrder, true, true, 2>(F.lds, g, S, E);
        GRID_BAR();
    }
    if (IN(15)) {
        if (!MK_ONE_LAUNCH) route_tables(F, cntg);
        const int ntl = (int)F.MISC[MW_NTILES];
        pg8::Gemm g{(const pg8::bf16_t*)H8, (const pg8::bf16_t*)Wde8, FFE, FFE, FFE};
        pg8::MoeOrder S; S.so.init(ntl < MAINTILES ? ntl : MAINTILES, D / 256, F.G, (int)blockIdx.x); S.texp = (const LAS int*)(F.MISC + MW_TEXP); S.estride = (size_t)D * FFE; S.rows = rowtok;
        pg8::EpiMoeDown E{YP, rowpair, roww, 1.f / (HSC * WSC_D)};
        pg8::gemm_phase<pg8::EpiMoeDown, pg8::MoeOrder, true, false, 1>(F.lds, g, S, E);
        if (ntl > MAINTILES) {
            pg8::Gemm g2{(const pg8::bf16_t*)H8, (const pg8::bf16_t*)Wde8, KSLICE, FFE, FFE};
            pg8::SplitOrder S2; S2.total = (ntl - MAINTILES) * 4 * NKS; S2.G = F.G; S2.c = (int)blockIdx.x; S2.tile0 = MAINTILES; S2.nks = NKS; S2.texp = (const LAS int*)(F.MISC + MW_TEXP); S2.estride = (size_t)D * FFE; S2.kslice = KSLICE; S2.rows = rowtok;
            pg8::EpiPartial E2{PARTB, roww, 1.f / (HSC * WSC_D), MAINTILES, LEFTTILES * 256};
            pg8::gemm_phase<pg8::EpiPartial, pg8::SplitOrder, true, false, 1>(F.lds, g2, S2, E2);
        }
        GRID_BAR();
    }
    if (IN(16)) {
        const unsigned bad = MK_ONE_LAUNCH ? __hip_atomic_load((unsigned*)(F.ctl + CW_BAR) + XB_TMO, RLX_AGENT) : 0u;
        f32x4 gq[4], bq[4];
#pragma unroll
        for (int j = 0; j < 2; ++j) { gq[2 * j] = *(const f32x4*)(ln_gain + 3 * D + 512 * j + 8 * F.lane); gq[2 * j + 1] = *(const f32x4*)(ln_gain + 3 * D + 512 * j + 8 * F.lane + 4);
            bq[2 * j] = *(const f32x4*)(ln_bias + 3 * D + 512 * j + 8 * F.lane); bq[2 * j + 1] = *(const f32x4*)(ln_bias + 3 * D + 512 * j + 8 * F.lane + 4); }
#define FIN_LOAD(m_, xw_, y0_, y1_) do { _Pragma("unroll") for (int j = 0; j < 2; ++j) { xw_[j] = *(const v4u*)(XB + (size_t)(m_) * D + 512 * j + 8 * F.lane); y0_[j] = *(const v4u*)(YP + (size_t)(2 * (m_)) * D + 512 * j + 8 * F.lane); y1_[j] = *(const v4u*)(YP + (size_t)(2 * (m_) + 1) * D + 512 * j + 8 * F.lane); } } while (0)
        v4u xwc[2], y0c[2], y1c[2], xwn[2], y0n[2], y1n[2];
        if (gw < T) FIN_LOAD(gw, xwc, y0c, y1c);
        for (int m = gw; m < T; m += NGW) {
            f32x4 v[4];
            if (m + NGW < T) FIN_LOAD(m + NGW, xwn, y0n, y1n);
            const int pp0 = __builtin_amdgcn_readfirstlane(pairpos[2 * m]), pp1 = __builtin_amdgcn_readfirstlane(pairpos[2 * m + 1]);
#pragma unroll
            for (int j = 0; j < 2; ++j) { const v4u xw = xwc[j], y0 = y0c[j], y1 = y1c[j];
                f32x4 a0 = (f32x4){bflo(y0.x), bfhi(y0.x), bflo(y0.y), bfhi(y0.y)}, a1 = (f32x4){bflo(y0.z), bfhi(y0.z), bflo(y0.w), bfhi(y0.w)};
                f32x4 b0 = (f32x4){bflo(y1.x), bfhi(y1.x), bflo(y1.y), bfhi(y1.y)}, b1 = (f32x4){bflo(y1.z), bfhi(y1.z), bflo(y1.w), bfhi(y1.w)};
                if (pp0 >= MAINTILES * 256) { a0 = (f32x4){0.f, 0.f, 0.f, 0.f}; a1 = a0;
                    for (int s = 0; s < NKS; ++s) { const float* pr = PARTB + ((size_t)s * (LEFTTILES * 256) + (pp0 - MAINTILES * 256)) * 1024 + 512 * j + 8 * F.lane; a0 += *(const f32x4*)pr; a1 += *(const f32x4*)(pr + 4); } }
                if (pp1 >= MAINTILES * 256) { b0 = (f32x4){0.f, 0.f, 0.f, 0.f}; b1 = b0;
                    for (int s = 0; s < NKS; ++s) { const float* pr = PARTB + ((size_t)s * (LEFTTILES * 256) + (pp1 - MAINTILES * 256)) * 1024 + 512 * j + 8 * F.lane; b0 += *(const f32x4*)pr; b1 += *(const f32x4*)(pr + 4); } }
                v[2 * j] = (f32x4){ALPHA * hlo(xw.x), ALPHA * hhi(xw.x), ALPHA * hlo(xw.y), ALPHA * hhi(xw.y)} + a0 + b0;
                v[2 * j + 1] = (f32x4){ALPHA * hlo(xw.z), ALPHA * hhi(xw.z), ALPHA * hlo(xw.w), ALPHA * hhi(xw.w)} + a1 + b1; }
            float s = 0.f;
#pragma unroll
            for (int j = 0; j < 4; ++j) s += (v[j].x + v[j].y) + (v[j].z + v[j].w);
            const float mean = wave_sum(s) * (1.f / D); float s2 = 0.f;
#pragma unroll
            for (int j = 0; j < 4; ++j) { v[j] = v[j] - mean; s2 += (v[j].x * v[j].x + v[j].y * v[j].y) + (v[j].z * v[j].z + v[j].w * v[j].w); }
            const float rstd = 1.f / sqrtf(wave_sum(s2) * (1.f / D) + LN_EPS);
            asm volatile("" ::: "memory");
#pragma unroll
            for (int j = 0; j < 2; ++j) { f32x4 o0 = v[2 * j] * rstd * gq[2 * j] + bq[2 * j], o1 = v[2 * j + 1] * rstd * gq[2 * j + 1] + bq[2 * j + 1];
                if (bad) { const float qn = __builtin_nanf(""); o0 = (f32x4){qn, qn, qn, qn}; o1 = o0; }
                *(f32x4*)(out + (size_t)m * D + 512 * j + 8 * F.lane) = o0; *(f32x4*)(out + (size_t)m * D + 512 * j + 8 * F.lane + 4) = o1; }
#pragma unroll
            for (int j = 0; j < 2; ++j) { xwc[j] = xwn[j]; y0c[j] = y0n[j]; y1c[j] = y1n[j]; }
        }
#undef FIN_LOAD
    }
#undef MOE_WITEM
#undef IN
#undef GRID_BAR
#undef LN_PHASE
#undef LN_LOAD
#undef LN_MIX
#undef LN_STORE_H
#undef LN_STORE_Q8
#undef x_in
#undef w_qkv_a
#undef w_o_a
#undef w_kv_sh
#undef w_q_b
#undef w_o_b
#undef sinks_b
#undef w_gate_d
#undef w_up_d
#undef w_down_d
#undef w_router
#undef w_gate_e
#undef w_up_e
#undef w_down_e
#undef ln_gain
#undef ln_bias
#undef Wqkv_t
#undef Woa_t
#undef Wgud_t
#undef Wdd_t
#undef Wqb_t
#undef Wob_t
#undef Wgue8
#undef Wde8
#undef X8
#undef H8
#undef XB
#undef QB
#undef KB
#undef VB
#undef HB
#undef kmean
#undef rowtok
#undef rowpair
#undef roww
#undef re
#undef rwf
#undef cntg
#undef pairpos
#undef PARTB
#undef YP
#undef X1H
#undef X2H
#undef X3H
#undef ws
}

extern "C" void kernel_launch(void* const* d_in, const int* in_sizes, int n_in, void* d_out, int out_size, void* d_ws, size_t ws_size, hipStream_t stream) {
    static int grid = 0;
    if (grid == 0) {
        if (n_in != 16 || in_sizes[0] != T * D || out_size != T * D || ws_size < WS_END) { fprintf(stderr, "kernel_launch: unexpected shapes / workspace (n_in %d, ws %zu); nothing launched\n", n_in, ws_size); grid = -1; return; }
        int dev = 0, cus = 0, per_cu = 0;
        if (hipGetDevice(&dev) != hipSuccess || hipDeviceGetAttribute(&cus, hipDeviceAttributeMultiprocessorCount, dev) != hipSuccess) { grid = -1; return; }
        if (hipFuncSetAttribute((const void*)fwd_kernel, hipFuncAttributeMaxDynamicSharedMemorySize, LDS_BYTES) != hipSuccess) { fprintf(stderr, "kernel_launch: hipFuncSetAttribute failed\n"); grid = -1; return; }
        if (hipOccupancyMaxActiveBlocksPerMultiprocessor(&per_cu, (const void*)fwd_kernel, NWAVES * 64, LDS_BYTES) != hipSuccess || per_cu < 1) fprintf(stderr, "kernel_launch: occupancy query reports %d\n", per_cu);
        (void)hipGetLastError();
        grid = cus > 256 ? 256 : cus;
    }
    if (grid < 0) return;
    if (hipMemsetAsync((char*)d_ws + WS_CTL, 0, CTL_ZERO_BYTES, stream) != hipSuccess) return;
    Args a{};
    for (int i = 0; i < 16; ++i) a.in[i] = (const float*)d_in[i];
    a.out = (float*)d_out; a.ws = (unsigned char*)d_ws;
#if MK_ONE_LAUNCH
    a.ph_lo = 0; a.ph_hi = N_PHASES;
    hipLaunchKernelGGL(fwd_kernel, dim3(grid), dim3(NWAVES * 64), LDS_BYTES, stream, a);
#else
    for (int p = 0; p < N_PHASES; ++p) { a.ph_lo = p; a.ph_hi = p + 1; hipLaunchKernelGGL(fwd_kernel, dim3(grid), dim3(NWAVES * 64), LDS_BYTES, stream, a); }
#endif
}
```
